# Optimizing an MI355X kernel written in HIP

```python
import jax, jax.numpy as jnp
from jax import lax
import numpy as np

D_MODEL = 2048
BATCH = 4
SEQ = 8192
DEPTH = 1

CHUNK = 64
N_MEM = 256
EPS = 1e-6

GMLP_BLOCK = 128
GMLP_WIDTH = D_MODEL // 2
GMLP_GROUPS = 8
GMLP_GROUP_DIM = GMLP_WIDTH // GMLP_GROUPS
CONV_WIDTH = D_MODEL // 2
CONV_K = 3
XATTN_HEADS = 4
XATTN_HEAD_DIM = 256
XATTN_WIDTH = XATTN_HEADS * XATTN_HEAD_DIM
N_BRANCH = 3
BRANCH_WIDTH = D_MODEL // 2
COL_A = 2 * GMLP_WIDTH
COL_B = 3 * CONV_WIDTH
COL_C = XATTN_WIDTH
COL_G = N_BRANCH * D_MODEL
D_IN = COL_A + COL_B + COL_C + COL_G
PEER_HEADS = 8
PEER_KEYS = 128
PEER_EXPERTS = PEER_KEYS * PEER_KEYS
PEER_TOPK = 16
PEER_HALF = 128
PEER_TOKEN_BLOCK = 128

kernel_name = 'hybrid_streaming_gmlp_conv_xattn_peer'


def rmsnorm(x, g):
    xf = x.astype(jnp.float32)
    y = xf * lax.rsqrt(jnp.mean(jnp.square(xf), axis=-1, keepdims=True) + EPS)
    return (y * g).astype(x.dtype)


def layernorm(x, g, b):
    xf = x.astype(jnp.float32)
    mu = jnp.mean(xf, axis=-1, keepdims=True)
    var = jnp.mean(jnp.square(xf - mu), axis=-1, keepdims=True)
    return ((xf - mu) * lax.rsqrt(var + EPS) * g + b).astype(x.dtype)


def chunk_causal_block_mask():
    c = jnp.arange(GMLP_BLOCK) // CHUNK
    return c[None, :] <= c[:, None]


def spatial_gating(z, w_s, b_s, ln_g, ln_b):
    u, v = jnp.split(z, 2, axis=-1)
    v = layernorm(v, ln_g, ln_b)
    bsz, s, _ = v.shape
    nb = s // GMLP_BLOCK
    v = v.reshape(bsz, nb, GMLP_BLOCK, GMLP_GROUPS, GMLP_GROUP_DIM)
    w = jnp.where(chunk_causal_block_mask()[None], w_s, 0.0).astype(v.dtype)
    sv = jnp.einsum('gij,bnjgc->bnigc', w, v) + b_s.T[:, :, None]
    return u * sv.reshape(bsz, s, GMLP_WIDTH)


def short_conv_mixer(z, conv_w):
    b_gate, c_gate, h = jnp.split(z, 3, axis=-1)
    y = lax.conv_general_dilated(
        c_gate * h, conv_w[:, None, :].astype(h.dtype),
        window_strides=(1,), padding=[(CONV_K - 1, 0)],
        dimension_numbers=('NWC', 'WIO', 'NWC'),
        feature_group_count=CONV_WIDTH)
    return b_gate * y


def memory_cross_attention(q, mem_n, w_kv):
    bsz, s, _ = q.shape
    m = mem_n.shape[1]
    k, v = jnp.split(mem_n @ w_kv, 2, axis=-1)
    q = q.reshape(bsz, s, XATTN_HEADS, XATTN_HEAD_DIM)
    k = k.reshape(bsz, m, XATTN_HEADS, XATTN_HEAD_DIM)
    v = v.reshape(bsz, m, XATTN_HEADS, XATTN_HEAD_DIM)
    sc = jnp.einsum('bshd,bmhd->bhsm', q, k).astype(jnp.float32) * (XATTN_HEAD_DIM ** -0.5)
    p = jax.nn.softmax(sc, axis=-1).astype(v.dtype)
    o = jnp.einsum('bhsm,bmhd->bshd', p, v)
    return o.reshape(bsz, s, XATTN_WIDTH)


def hybrid_mixer(h, mem_n, w_in, w_s, b_s, ln_g, ln_b, conv_w, w_kv, w_branch, w_out):
    bsz, s, _ = h.shape
    z = h @ w_in
    z_a, z_b, z_c, z_g = jnp.split(z, [COL_A, COL_A + COL_B, COL_A + COL_B + COL_C], axis=-1)
    gates = z_g.reshape(bsz, s, N_BRANCH, D_MODEL)
    branches = (spatial_gating(jax.nn.gelu(z_a), w_s, b_s, ln_g, ln_b),
                short_conv_mixer(z_b, conv_w),
                memory_cross_attention(z_c, mem_n, w_kv))
    merged = jnp.zeros((bsz, s, D_MODEL), h.dtype)
    for n in range(N_BRANCH):
        merged = merged + jax.nn.sigmoid(gates[:, :, n]) * (branches[n] @ w_branch[n])
    return merged @ w_out


def peer_retrieve(h, w_q, sub_keys):
    t = h.shape[0]
    q = (h @ w_q).reshape(t, PEER_HEADS, 2, PEER_HALF)
    sc = jnp.einsum('thpc,hpkc->thpk', q, sub_keys).astype(jnp.float32)
    top_s, top_i = lax.top_k(sc, PEER_TOPK)
    cand_s = (top_s[:, :, 0, :, None] + top_s[:, :, 1, None, :]).reshape(t, PEER_HEADS, PEER_TOPK * PEER_TOPK)
    cand_i = (top_i[:, :, 0, :, None] * PEER_KEYS + top_i[:, :, 1, None, :]).reshape(t, PEER_HEADS, PEER_TOPK * PEER_TOPK)
    best_s, pos = lax.top_k(cand_s, PEER_TOPK)
    idx = jnp.take_along_axis(cand_i, pos, axis=-1)
    g = jax.nn.softmax(best_s, axis=-1)
    return idx, g


def peer_experts(h, idx, g, w_down, w_up):
    t, d = h.shape
    nb = t // PEER_TOKEN_BLOCK

    def block(args):
        hb, ib, gb = args
        u = jnp.take(w_down, ib, axis=0)
        a = jax.nn.gelu(jnp.einsum('thkd,td->thk', u, hb))
        v = jnp.take(w_up, ib, axis=0)
        return jnp.einsum('thk,thkd->td', a * gb.astype(a.dtype), v)

    out = lax.map(block, (h.reshape(nb, PEER_TOKEN_BLOCK, d),
                          idx.reshape(nb, PEER_TOKEN_BLOCK, PEER_HEADS, PEER_TOPK),
                          g.reshape(nb, PEER_TOKEN_BLOCK, PEER_HEADS, PEER_TOPK)))
    return out.reshape(t, d)


def setup_inputs(seed: int = 0) -> dict:
    key = jax.random.key(seed)
    ks = jax.random.split(key, 20)
    f32 = jnp.float32
    nrm = lambda k, shape, scale: jax.random.normal(k, shape, f32) * scale
    gain = lambda k, shape: 1.0 + 0.02 * jax.random.normal(k, shape, f32)
    L = DEPTH
    return {
        'x': jax.random.normal(ks[0], (BATCH, SEQ, D_MODEL), f32),
        'mem': jax.random.normal(ks[1], (BATCH, N_MEM, D_MODEL), f32),
        'norm_mix_g': gain(ks[2], (L, D_MODEL)),
        'norm_mem_g': gain(ks[3], (L, D_MODEL)),
        'w_in': nrm(ks[4], (L, D_MODEL, D_IN), D_MODEL ** -0.5),
        'gmlp_w_s': nrm(ks[5], (L, GMLP_GROUPS, GMLP_BLOCK, GMLP_BLOCK), 0.5 * GMLP_BLOCK ** -0.5),
        'gmlp_b_s': 1.0 + 0.01 * jax.random.normal(ks[6], (L, GMLP_GROUPS, GMLP_BLOCK), f32),
        'gmlp_ln_g': gain(ks[7], (L, GMLP_WIDTH)),
        'gmlp_ln_b': nrm(ks[8], (L, GMLP_WIDTH), 0.01),
        'conv_w': nrm(ks[9], (L, CONV_K, CONV_WIDTH), CONV_K ** -0.5),
        'w_kv': nrm(ks[10], (L, D_MODEL, 2 * XATTN_WIDTH), D_MODEL ** -0.5),
        'w_branch': nrm(ks[11], (L, N_BRANCH, BRANCH_WIDTH, D_MODEL), BRANCH_WIDTH ** -0.5),
        'w_out': nrm(ks[12], (L, D_MODEL, D_MODEL), D_MODEL ** -0.5),
        'norm_ffn_g': gain(ks[13], (L, D_MODEL)),
        'peer_w_q': nrm(ks[14], (L, D_MODEL, PEER_HEADS * 2 * PEER_HALF), D_MODEL ** -0.5),
        'peer_keys': nrm(ks[15], (L, PEER_HEADS, 2, PEER_KEYS, PEER_HALF), PEER_HALF ** -0.5),
        'peer_w_down': nrm(ks[16], (L, PEER_EXPERTS, D_MODEL), D_MODEL ** -0.5),
        'peer_w_up': nrm(ks[17], (L, PEER_EXPERTS, D_MODEL), PEER_HEADS ** -0.5),
        'norm_final_g': gain(ks[18], (D_MODEL,)),
    }


def reference(x, mem, norm_mix_g, norm_mem_g, w_in, gmlp_w_s, gmlp_b_s, gmlp_ln_g, gmlp_ln_b,
              conv_w, w_kv, w_branch, w_out, norm_ffn_g, peer_w_q, peer_keys, peer_w_down,
              peer_w_up, norm_final_g):
    bsz, s, d = x.shape
    for l in range(DEPTH):
        h = rmsnorm(x, norm_mix_g[l])
        m = rmsnorm(mem, norm_mem_g[l])
        x = x + hybrid_mixer(h, m, w_in[l], gmlp_w_s[l], gmlp_b_s[l], gmlp_ln_g[l], gmlp_ln_b[l],
                             conv_w[l], w_kv[l], w_branch[l], w_out[l])
        h = rmsnorm(x, norm_ffn_g[l]).reshape(bsz * s, d)
        idx, g = peer_retrieve(h, peer_w_q[l], peer_keys[l])
        x = x + peer_experts(h, idx, g, peer_w_down[l], peer_w_up[l]).reshape(bsz, s, d)
    return rmsnorm(x, norm_final_g)
```

```cpp
#include <hip/hip_runtime.h>
#include <cstdio>
#include <cstdint>

#ifndef MK_SPLIT
#define MK_SPLIT 0
#endif
#ifndef PH_MASK
#define PH_MASK 0x3FF
#endif
#ifndef MK_SEQ
#define MK_SEQ {0, 1, 2, 3, 4, 5, 6, 7, 8, 9}
#endif
#ifndef P2_REP_G
#define P2_REP_G 1
#endif
#ifndef P2_REP_C
#define P2_REP_C 1
#endif
#ifndef P2_REP_A
#define P2_REP_A 1
#endif
#ifndef P8X_REP
#define P8X_REP 1
#endif
#ifndef P7Y_REP
#define P7Y_REP 1
#endif
#ifndef P7X_REP
#define P7X_REP 1
#endif

#define LAS __attribute__((address_space(3)))
#define GAS __attribute__((address_space(1)))
typedef unsigned short bf16_t;
typedef short bf16x8 __attribute__((ext_vector_type(8)));
typedef float f32x2 __attribute__((ext_vector_type(2)));
typedef float f32x4 __attribute__((ext_vector_type(4)));
typedef float f32x16 __attribute__((ext_vector_type(16)));
typedef unsigned u32x2 __attribute__((ext_vector_type(2)));
typedef unsigned u32x4 __attribute__((ext_vector_type(4)));
typedef __bf16 bf16x2_t __attribute__((ext_vector_type(2)));
typedef unsigned u32x16 __attribute__((ext_vector_type(16)));
typedef int i32x4 __attribute__((ext_vector_type(4)));
typedef unsigned u32x6 __attribute__((ext_vector_type(6)));
typedef unsigned u32x3 __attribute__((ext_vector_type(3)));
typedef float f32x32 __attribute__((ext_vector_type(32)));
typedef int i32x8 __attribute__((ext_vector_type(8)));

constexpr int BATCH = 4, SEQ = 8192, D = 2048, M = BATCH * SEQ, NMEM = 256, MM = BATCH * NMEM;
constexpr int DIN = 12288;
constexpr float EPS = 1e-6f;
constexpr int NWAVES = 8;
constexpr int NPHASE = 10;

constexpr size_t MiB = 1u << 20;
constexpr size_t WS_CTL = 0, CTL_ZERO_BYTES = 1 * MiB;
constexpr size_t WS_SSP = 1 * MiB;
constexpr size_t WS_WIN = 5 * MiB;
constexpr size_t WS_WKV = 53 * MiB;
constexpr size_t WS_WB = 61 * MiB;
constexpr size_t WS_WOUT = 73 * MiB;
constexpr size_t WS_WQ = 81 * MiB;
constexpr size_t WS_KEYF = 89 * MiB;
constexpr size_t WS_WSM = 89 * MiB + 512 * 1024;
constexpr size_t WS_MEMN = 90 * MiB;
constexpr size_t WS_KF = 94 * MiB;
constexpr size_t WS_VF = 96 * MiB;
constexpr size_t WS_SCU = 162 * MiB + 65536;
constexpr size_t WS_H1 = 226 * MiB;
constexpr size_t WS_GA = 354 * MiB;
constexpr size_t WS_BG = 482 * MiB;
constexpr size_t WS_CH = 546 * MiB;
constexpr size_t WS_Q = 610 * MiB;
constexpr size_t WS_SG8 = 674 * MiB;
constexpr size_t WS_PQ = 674 * MiB;
constexpr size_t WS_IDX = 802 * MiB;
constexpr size_t WS_GW = 818 * MiB;
constexpr size_t WS_YC = 930 * MiB;
constexpr size_t WS_PO = 226 * MiB;
constexpr size_t WS_YA = 866 * MiB;
constexpr size_t WS_H8 = 930 * MiB;
constexpr size_t WS_END = 994 * MiB;
constexpr size_t WS_W8 = 25 * MiB;
constexpr size_t WS_HS = 162 * MiB + 131072;
constexpr size_t WS_WU4 = 130 * MiB;
constexpr size_t WS_CB = 834 * MiB;
constexpr size_t WS_WD4 = 98 * MiB;
constexpr size_t WS_WDS = 114 * MiB;
constexpr size_t WS_PART = 482 * MiB;
constexpr size_t WS_RS = 162 * MiB + 262144;
constexpr size_t CTL_P7Q = 768 * 1024;
constexpr size_t CTL_CMX = 512 * 1024;
constexpr int CW_TMO = 0, CW_BAR = 4096;

constexpr int RING_BYTES = 131072, LDSCTL_OFF = RING_BYTES, LDS_BYTES = 147456;

__device__ __forceinline__ unsigned pk2(float lo, float hi) { f32x2 v = {lo, hi}; bf16x2_t b = __builtin_convertvector(v, bf16x2_t); return __builtin_bit_cast(unsigned, b); }
__device__ __forceinline__ float bf_lo(unsigned u) { return __uint_as_float(u << 16); }
__device__ __forceinline__ float bf_hi(unsigned u) { return __uint_as_float(u & 0xffff0000u); }
__device__ __forceinline__ float gelu_tanh(float x) {
    const float t = x * (1.0f + 0.044715f * x * x) * (-2.302208198f);
    return x * __builtin_amdgcn_rcpf(1.0f + __builtin_amdgcn_exp2f(t));
}
__device__ __forceinline__ float sigmoidf_(float x) { return __builtin_amdgcn_rcpf(1.0f + __builtin_amdgcn_exp2f(x * -1.44269504f)); }
__device__ __forceinline__ float wave_sum(float v) {
#pragma unroll
    for (int o = 1; o < 64; o <<= 1) v += __shfl_xor(v, o);
    return v;
}
#define MFMA32(a, b, c) __builtin_amdgcn_mfma_f32_32x32x16_bf16((a), (b), (c), 0, 0, 0)

namespace pg8 {
constexpr int BM = 256, BK = 64, HALF = 128, HTB = HALF * BK * 2, STAGE_BYTES = 8 * HTB;
__host__ __device__ __forceinline__ int lds_byte(int r, int c) { const int st = (r >> 4) * 2 + (c >> 5), rr = r & 15, cc = c & 31, ob = rr * 64 + cc * 2; return st * 1024 + (ob ^ (((ob >> 9) & 1) << 5)); }
__host__ __device__ __forceinline__ void stage_rc(int b, int& R, int& C) { const int st = b / 1024, sb = b % 1024, swz = sb ^ (((sb >> 9) & 1) << 5); R = (st >> 1) * 16 + swz / 64; C = (st & 1) * 32 + (swz % 64) / 2; }
__host__ __device__ __forceinline__ int perm32(int rho) { const int n = rho >> 4, i = rho & 15; return 8 * (i >> 2) + 4 * n + (i & 3); }

struct Unit { int pm, pn, kind, aux; unsigned a, b; };

__device__ __forceinline__ void tile_map(int L, int nM, int nN, int& pm, int& pn) {
    const int nwg = nM * nN; int wgid = L;
    { const int q = nwg / 8, r = nwg % 8, xcd = wgid % 8, off = wgid / 8; wgid = (xcd < r ? xcd * (q + 1) : r * (q + 1) + (xcd - r) * q) + off; }
    const int nig = 8 * nN, gid = wgid / nig, fm = gid * 8, gsz = (nM - fm) < 8 ? (nM - fm) : 8;
    pm = fm + ((wgid % nig) % gsz); pn = (wgid % nig) / gsz;
}

template <class Epi, class Sched, int MODE = 0>
__device__ __forceinline__ void gemm_phase(LAS unsigned char* lds, const unsigned char* wsbase, const int K, const Sched& S, const Epi& E) {
    const __amdgpu_buffer_rsrc_t rsrc = __builtin_amdgcn_make_buffer_rsrc((void*)wsbase, 0, 0x7FFFFFFF, 0x00020000);
    int tid = threadIdx.x; asm volatile("" : "+v"(tid));
    const int wid = __builtin_amdgcn_readfirstlane(tid >> 6), lane = tid & 63, wr = wid >> 2, wc = wid & 3, fr = lane & 15, fq = lane >> 4;
    const int nt = K / BK;
    unsigned voffA[2], voffB[2];
#pragma unroll
    for (int i = 0; i < 2; ++i) { int R, C; stage_rc(tid * 16 + i * 8192, R, C); const int Rb = (R & ~31) + perm32(R & 31);
        voffA[i] = (unsigned)(R * K + C) * 2u; voffB[i] = (unsigned)(Rb * K + C) * 2u; }
    const unsigned kstep = (unsigned)(BK * 2);
    const unsigned hstep = (unsigned)HALF * K * 2;
    const unsigned ldsw = (unsigned)wid * 1024u;
    const int aoff = lds_byte(wr * 64 + fr, fq * 8), boff = lds_byte(wc * 32 + fr, fq * 8);
#define PG8_SA(b, h) (((b) * 2 + (h)) * HTB)
#define PG8_SB(b, h) ((4 + (b) * 2 + (h)) * HTB)
#define PG8_STAGE(bufoff, gbase, voff) do { _Pragma("unroll") for (int _i = 0; _i < 2; ++_i) \
        __builtin_amdgcn_raw_ptr_buffer_load_lds(rsrc, (LAS void*)(lds + (bufoff) + ldsw + _i * 8192), 16, (int)(voff)[_i], (int)(gbase), 0, 0); } while (0)
#define PG8_LDA(dst, b, h) do { _Pragma("unroll") for (int m = 0; m < 4; ++m) _Pragma("unroll") for (int k = 0; k < 2; ++k) dst[m][k] = *(const LAS bf16x8*)(lds + PG8_SA(b, h) + aoff + m * 2048 + k * 1024); } while (0)
#define PG8_LDB(dst, b, h) do { _Pragma("unroll") for (int n = 0; n < 2; ++n) _Pragma("unroll") for (int k = 0; k < 2; ++k) dst[n][k] = *(const LAS bf16x8*)(lds + PG8_SB(b, h) + boff + n * 2048 + k * 1024); } while (0)
#define PG8_CAT(x) __builtin_shufflevector(__builtin_bit_cast(i32x4, x[0]), __builtin_bit_cast(i32x4, x[1]), 0, 1, 2, 3, 4, 5, 6, 7)
#define PG8_MMA(ai, bj, At, Bt) do { __builtin_amdgcn_s_setprio(1); _Pragma("unroll") for (int m = 0; m < 4; ++m) _Pragma("unroll") for (int n = 0; n < 2; ++n) { \
        if constexpr (MODE == 1) acc[ai][bj][m][n] = __builtin_amdgcn_mfma_scale_f32_16x16x128_f8f6f4(PG8_CAT(Bt[n]), PG8_CAT(At[m]), acc[ai][bj][m][n], 0, 0, 0, 0, 0, 0); \
        else if constexpr (MODE == 2) { _Pragma("unroll") for (int k = 0; k < 2; ++k) acc[ai][bj][m][n] = __builtin_bit_cast(f32x4, __builtin_amdgcn_mfma_i32_16x16x64_i8(__builtin_bit_cast(i32x4, Bt[n][k]), __builtin_bit_cast(i32x4, At[m][k]), __builtin_bit_cast(i32x4, acc[ai][bj][m][n]), 0, 0, 0)); } \
        else { _Pragma("unroll") for (int k = 0; k < 2; ++k) acc[ai][bj][m][n] = __builtin_amdgcn_mfma_f32_16x16x32_bf16(Bt[n][k], At[m][k], acc[ai][bj][m][n], 0, 0, 0); } } \
        __builtin_amdgcn_s_setprio(0); } while (0)
#define PG8_WAIT_V(n) asm volatile("s_waitcnt vmcnt(" #n ")" ::: "memory")
#define PG8_WAIT_L(n) asm volatile("s_waitcnt lgkmcnt(" #n ")" ::: "memory")
#define PG8_BAR __builtin_amdgcn_s_barrier()
#define PG8_SCHED __builtin_amdgcn_sched_barrier(0)
    Unit cur, nxt; int ui = 0;
    if (!S.next(0, cur)) return;
    f32x4 acc[2][2][4][2];
#pragma unroll
    for (int a = 0; a < 2; ++a)
#pragma unroll
        for (int b = 0; b < 2; ++b)
#pragma unroll
            for (int m = 0; m < 4; ++m)
#pragma unroll
                for (int n = 0; n < 2; ++n) acc[a][b][m][n] = (f32x4){0.f, 0.f, 0.f, 0.f};
    bf16x8 At[4][2], B0[2][2], B1[2][2];
    unsigned cA = cur.a, cB = cur.b;
    PG8_STAGE(PG8_SB(0, 0), cB, voffB); PG8_STAGE(PG8_SB(0, 1), cB + hstep, voffB); PG8_STAGE(PG8_SA(0, 0), cA, voffA); PG8_STAGE(PG8_SA(0, 1), cA + hstep, voffA);
    if (wr == 1) PG8_BAR;
    PG8_WAIT_V(2); PG8_BAR;
    PG8_STAGE(PG8_SB(1, 0), cB + kstep, voffB); PG8_STAGE(PG8_SA(1, 0), cA + kstep, voffA); PG8_STAGE(PG8_SB(1, 1), cB + hstep + kstep, voffB);
    PG8_WAIT_V(6); PG8_BAR;
    for (;;) {
        const bool has_next = S.next(ui + 1, nxt);
        const unsigned nA = has_next ? nxt.a : cA, nB = has_next ? nxt.b : cB;
        for (int t = 0; t < nt; t += 2) {
            const bool last = (t == nt - 2);
            const unsigned a1 = cA + (unsigned)(t + 1) * kstep;
            const unsigned a2 = last ? nA : cA + (unsigned)(t + 2) * kstep, b2 = last ? nB : cB + (unsigned)(t + 2) * kstep;
            const unsigned a3 = a2 + kstep, b3 = b2 + kstep;
            PG8_LDB(B0, 0, 0); PG8_LDB(B1, 0, 1); PG8_SCHED; PG8_LDA(At, 0, 0); PG8_STAGE(PG8_SA(1, 1), a1 + hstep, voffA);
            PG8_WAIT_V(8); PG8_WAIT_L(0); PG8_BAR; PG8_MMA(0, 0, At, B0); PG8_MMA(0, 1, At, B1); PG8_BAR; PG8_SCHED;
            PG8_LDA(At, 0, 1); PG8_STAGE(PG8_SB(0, 0), b2, voffB); PG8_STAGE(PG8_SB(0, 1), b2 + hstep, voffB); PG8_STAGE(PG8_SA(0, 0), a2, voffA);
            PG8_WAIT_V(8); PG8_WAIT_L(0); PG8_BAR; PG8_MMA(1, 0, At, B0); PG8_MMA(1, 1, At, B1); PG8_BAR; PG8_SCHED;
            PG8_LDB(B0, 1, 0); PG8_LDB(B1, 1, 1); PG8_SCHED; PG8_LDA(At, 1, 0); PG8_STAGE(PG8_SA(0, 1), a2 + hstep, voffA);
            PG8_WAIT_V(8); PG8_WAIT_L(0); PG8_BAR; PG8_MMA(0, 0, At, B0); PG8_MMA(0, 1, At, B1); PG8_BAR; PG8_SCHED;
            PG8_LDA(At, 1, 1); PG8_STAGE(PG8_SB(1, 0), b3, voffB); PG8_STAGE(PG8_SB(1, 1), b3 + hstep, voffB); PG8_STAGE(PG8_SA(1, 0), a3, voffA);
            PG8_WAIT_V(8); PG8_WAIT_L(0); PG8_BAR; PG8_MMA(1, 0, At, B0); PG8_MMA(1, 1, At, B1); PG8_BAR; PG8_SCHED;
        }
        if (wr == 0) PG8_BAR;
        E(acc, cur, wr, wc, fr, fq);
        if (!has_next) break;
        if constexpr (!Epi::CHAIN) {
#pragma unroll
        for (int a = 0; a < 2; ++a)
#pragma unroll
            for (int b = 0; b < 2; ++b)
#pragma unroll
                for (int m = 0; m < 4; ++m)
#pragma unroll
                    for (int n = 0; n < 2; ++n) acc[a][b][m][n] = (f32x4){0.f, 0.f, 0.f, 0.f};
        }
        cur = nxt; cA = nA; cB = nB; ++ui;
        if (wr == 1) PG8_BAR;
    }
    PG8_WAIT_V(0);
    PG8_BAR;
#undef PG8_SA
#undef PG8_SB
#undef PG8_STAGE
#undef PG8_LDA
#undef PG8_LDB
#undef PG8_MMA
#undef PG8_CAT
#undef PG8_WAIT_V
#undef PG8_WAIT_L
#undef PG8_BAR
#undef PG8_SCHED
}
}
using pg8::Unit;

#define XB_TMO      128
#define XB_XCNT(j)  (256  + 64 * (j))
#define XB_XSUB(j)  (1280 + 64 * (j))
#define XB_XGEN(j)  (2304 + 64 * (j))
#define XB_TOP      3328
#define XB_TOPGEN   3392
#define XCD_BAR_WORDS 3456
#define XB_SPIN_CAP (1u << 18)
__device__ __forceinline__ unsigned xb_ld(unsigned* p)              { return __hip_atomic_load(p, __ATOMIC_RELAXED, __HIP_MEMORY_SCOPE_AGENT); }
__device__ __forceinline__ unsigned xb_add(unsigned* p, unsigned v) { return __hip_atomic_fetch_add(p, v, __ATOMIC_RELAXED, __HIP_MEMORY_SCOPE_AGENT); }
__device__ __forceinline__ unsigned xb_xcc_id() { return (unsigned)__builtin_amdgcn_s_getreg((3 << 11) | 20) & 0xFu; }
#define XB_SPIN(cond, bar) do { unsigned _sp = 0; while (cond) { __builtin_amdgcn_s_sleep(1); \
    if ((++_sp & 255u) == 0u) { if (xb_ld(&(bar)[XB_TMO])) break; if (_sp > XB_SPIN_CAP) { atomicAdd(&(bar)[XB_TMO], 1u); break; } } } } while (0)
struct XcdBarrier { unsigned* bar; unsigned x; volatile LAS unsigned* st; };
__device__ __forceinline__ XcdBarrier xcd_barrier_post(unsigned* bar, volatile LAS unsigned* st) {
    XcdBarrier b; b.bar = bar; b.x = xb_xcc_id(); b.st = st;
    if (threadIdx.x == 0) (void)xb_add(&bar[XB_XCNT(b.x)], 1u);
    return b;
}
__device__ __forceinline__ void xcd_barrier_complete(unsigned* bar, unsigned x, unsigned& nloc, unsigned& nx) {
    const unsigned G = gridDim.x * gridDim.y * gridDim.z;
    unsigned sum, cnt, mine, sp = 0u;
    for (;;) {
        sum = 0u; cnt = 0u; mine = 0u;
#pragma unroll
        for (unsigned j = 0; j < 16; ++j) { const unsigned c = xb_ld(&bar[XB_XCNT(j)]); sum += c; cnt += (c > 0u) ? 1u : 0u; mine = (j == x) ? c : mine; }
        if (sum == G) break;
        __builtin_amdgcn_s_sleep(1);
        if ((++sp & 255u) == 0u) { if (xb_ld(&bar[XB_TMO])) break; if (sp > XB_SPIN_CAP) { atomicAdd(&bar[XB_TMO], 1u); break; } }
    }
    nloc = mine > 0u ? mine : 1u; nx = cnt > 0u ? cnt : 1u;
}
__device__ __forceinline__ void xcd_barrier(const XcdBarrier& b) {
    asm volatile("s_waitcnt vmcnt(0)" ::: "memory");
    __syncthreads();
    if (threadIdx.x == 0) {
        unsigned* bar = b.bar;
        __builtin_amdgcn_s_waitcnt(0);
        unsigned nloc = b.st[0], nx = b.st[1];
        if (nloc == 0u) { xcd_barrier_complete(bar, b.x, nloc, nx); b.st[0] = nloc; b.st[1] = nx; }
        const unsigned old = xb_add(&bar[XB_XSUB(b.x)], 1u);
        const unsigned gen = old / nloc;
        if (old + 1u == (gen + 1u) * nloc) {
            __builtin_amdgcn_fence(__ATOMIC_RELEASE, "agent");
            asm volatile("s_waitcnt vmcnt(0)" ::: "memory");
            const unsigned og = xb_add(&bar[XB_TOP], 1u);
            const unsigned tg = og / nx;
            if (og + 1u == (tg + 1u) * nx) xb_add(&bar[XB_TOPGEN], 1u);
            else XB_SPIN(xb_ld(&bar[XB_TOPGEN]) == tg, bar);
            __builtin_amdgcn_fence(__ATOMIC_ACQUIRE, "agent");
            xb_add(&bar[XB_XGEN(b.x)], 1u);
            asm volatile("s_waitcnt vmcnt(0)" ::: "memory");
        } else {
            XB_SPIN(xb_ld(&bar[XB_XGEN(b.x)]) == gen, bar);
            __builtin_amdgcn_fence(__ATOMIC_ACQUIRE, "agent");
            asm volatile("s_waitcnt vmcnt(0)" ::: "memory");
        }
    }
    __syncthreads();
}

constexpr unsigned TSTEP2048 = 256u * 2048u * 2u, TSTEP1024 = 256u * 1024u * 2u;
struct SchedP1 {
    int G, c; unsigned H1, WIN, MEMN, WKV; int first, count;
    __device__ __forceinline__ bool next(int i, Unit& u) const {
        const int Lr = i * G + c, L = first + Lr;
        if (Lr >= count) return false;
        const bool kv = L < 32;
        const unsigned isv = (unsigned)(L >> 4) & 1u, j = (unsigned)(L & 15);
        const unsigned ak = MEMN + (j >> 2) * TSTEP2048, bk = WKV + (j & 3) * TSTEP2048, av = WKV + (4u + (j >> 2)) * TSTEP2048, bv = MEMN + (j & 3) * TSTEP2048;
        int pm, pn; pg8::tile_map(kv ? 0 : L - 32, 128, 20, pm, pn);
        const int kt = pn < 8 ? 0 : (pn < 12 ? 1 : 2);
        u.pm = kv ? (int)(j >> 2) : pm; u.pn = kv ? (int)(j & 3) : pn; u.kind = kv ? 5 + (int)isv : kt; u.aux = 0;
        u.a = kv ? ak + isv * (av - ak) : H1 + (unsigned)pm * TSTEP2048;
        u.b = kv ? bk + isv * (bv - bk) : WIN + (unsigned)pn * TSTEP2048;
        return true;
    }
};
struct SchedP1F {
    int G, c; unsigned H8, W8;
    __device__ __forceinline__ bool next(int i, Unit& u) const {
        const int L = i * G + c;
        if (L >= 128 * 48) return false;
        pg8::tile_map(L, 128, 48, u.pm, u.pn);
        u.a = H8 + (unsigned)u.pm * TSTEP1024; u.b = W8 + (unsigned)u.pn * TSTEP1024;
        u.kind = u.pn < 8 ? 0 : (u.pn < 12 ? 1 : (u.pn < 20 ? 2 : (u.pn < 24 ? 3 : 4))); u.aux = 0;
        return true;
    }
};
struct SchedP3 {
    int G, c;
    __device__ __forceinline__ bool next(int i, Unit& u) const {
        const int n = i % 3, L = (i / 3) * G + c;
        if (L >= 128 * 8) return false;
        pg8::tile_map(L, 128, 8, u.pm, u.pn);
        u.aux = n; u.kind = 0;
        const unsigned aoff = (n == 0) ? (unsigned)WS_YA : ((n == 1) ? (unsigned)WS_BG : (unsigned)WS_YC);
        u.a = aoff + (unsigned)u.pm * TSTEP1024;
        u.b = (unsigned)WS_WB + (unsigned)n * (2048u * 1024u * 2u) + (unsigned)u.pn * TSTEP1024;
        return true;
    }
};
struct SchedSimple {
    int G, c, nM, nN; unsigned A, B;
    __device__ __forceinline__ bool next(int i, Unit& u) const {
        const int L = i * G + c;
        if (L >= nM * nN) return false;
        pg8::tile_map(L, nM, nN, u.pm, u.pn);
        u.a = A + (unsigned)u.pm * TSTEP2048; u.b = B + (unsigned)u.pn * TSTEP2048; u.kind = 0; u.aux = 0;
        return true;
    }
};

#define EPI_ROWS _Pragma("unroll") for (int ai = 0; ai < 2; ++ai) _Pragma("unroll") for (int m = 0; m < 4; ++m)
#define EPI_BJ _Pragma("unroll") for (int bj = 0; bj < 2; ++bj)
__device__ __forceinline__ u32x4 pack8(const f32x4 v0, const f32x4 v1) { u32x4 w; w.x = pk2(v0[0], v0[1]); w.y = pk2(v0[2], v0[3]); w.z = pk2(v1[0], v1[1]); w.w = pk2(v1[2], v1[3]); return w; }

struct EpiP1 {
    static constexpr bool CHAIN = false;
    bf16_t *GA, *BG, *CH, *KF, *VF;
    __device__ __forceinline__ void operator()(const f32x4 (&acc)[2][2][4][2], const Unit& u, int wr, int wc, int fr, int fq) const {
        asm volatile("" : "+v"(fr), "+v"(fq));
        const int rt0 = 64 * wr + fr, ct0 = 32 * wc + 8 * fq;
        if (u.kind == 0) {
            EPI_ROWS { const int row = u.pm * 256 + 128 * ai + 16 * m + rt0; bf16_t* rp = GA + (size_t)row * 2048 + u.pn * 256 + ct0;
                EPI_BJ { f32x4 v0 = acc[ai][bj][m][0], v1 = acc[ai][bj][m][1];
#pragma unroll
                    for (int j = 0; j < 4; ++j) { v0[j] = gelu_tanh(v0[j]); v1[j] = gelu_tanh(v1[j]); }
                    *(u32x4*)(rp + bj * 128) = pack8(v0, v1); } }
        } else if (u.kind == 1) {
            EPI_ROWS { const int row = u.pm * 256 + 128 * ai + 16 * m + rt0; bf16_t* rp = BG + (size_t)row * 1024 + (u.pn - 8) * 256 + ct0;
                EPI_BJ { *(u32x4*)(rp + bj * 128) = pack8(acc[ai][bj][m][0], acc[ai][bj][m][1]); } }
        } else if (u.kind == 2) {
            EPI_ROWS { const int row = u.pm * 256 + 128 * ai + 16 * m + rt0; bf16_t* rp = CH + (size_t)row * 1024 + (u.pn - 12) * 128 + ct0;
                *(u32x4*)rp = pack8(acc[ai][0][m][0] * acc[ai][1][m][0], acc[ai][0][m][1] * acc[ai][1][m][1]); }
        } else if (u.kind == 5) {
            EPI_ROWS { const int key = 128 * ai + 16 * m + rt0;
                EPI_BJ { const int d = ct0 + 128 * bj;
                    const size_t o = ((((size_t)(u.pm * 4 + u.pn) * 8 + (key >> 5)) * 16 + (d >> 4)) * 64 + (key & 31) + 32 * ((d >> 3) & 1)) * 8;
                    *(u32x4*)(KF + o) = pack8(acc[ai][bj][m][0], acc[ai][bj][m][1]); } }
        } else {
            EPI_ROWS { const int d = 128 * ai + 16 * m + rt0;
                EPI_BJ { const int c = ct0 + 128 * bj; const int kstep = (c >> 4), jh = (c >> 3) & 1;
                    const size_t o = ((((size_t)(u.pn * 4 + u.pm) * 8 + (d >> 5)) * 16 + kstep) * 64 + (d & 31)) * 8 + 4 * jh;
                    const f32x4 v0 = acc[ai][bj][m][0], v1 = acc[ai][bj][m][1];
                    u32x2 w0, w1; w0.x = pk2(v0[0], v0[1]); w0.y = pk2(v0[2], v0[3]); w1.x = pk2(v1[0], v1[1]); w1.y = pk2(v1[2], v1[3]);
                    *(u32x2*)(VF + o) = w0; *(u32x2*)(VF + o + 32 * 8) = w1; } }
        }
    }
};
__device__ __forceinline__ f32x4 i2f4(const f32x4 a) { const i32x4 i = __builtin_bit_cast(i32x4, a); return (f32x4){(float)i[0], (float)i[1], (float)i[2], (float)i[3]}; }
struct EpiP1F {
    static constexpr bool CHAIN = false;
    bf16_t *GA, *BG, *CH, *Q; unsigned char* SG8; const float* HS; const unsigned* CMX;
    __device__ __forceinline__ void operator()(const f32x4 (&acc)[2][2][4][2], const Unit& u, int wr, int wc, int fr, int fq) const {
        asm volatile("" : "+v"(fr), "+v"(fq));
        const int rt0 = 64 * wr + fr, ct0 = 32 * wc + 8 * fq;
        f32x4 cs[2][2];
#pragma unroll
        for (int bj = 0; bj < 2; ++bj)
#pragma unroll
            for (int n = 0; n < 2; ++n) { const u32x4 cb = *(const u32x4*)(CMX + u.pn * 256 + ct0 + 128 * bj + 4 * n);
#pragma unroll
                for (int j = 0; j < 4; ++j) cs[bj][n][j] = __uint_as_float(cb[j]) * (1.0f / 127.0f); }
        float sa8[2][4];
        EPI_ROWS { sa8[ai][m] = HS[u.pm * 256 + 128 * ai + 16 * m + rt0]; }
        if (u.kind == 0) {
            EPI_ROWS { const int row = u.pm * 256 + 128 * ai + 16 * m + rt0; bf16_t* rp = GA + (size_t)row * 2048 + u.pn * 256 + ct0; const float sa = sa8[ai][m];
                EPI_BJ { f32x4 v0 = i2f4(acc[ai][bj][m][0]) * cs[bj][0] * sa, v1 = i2f4(acc[ai][bj][m][1]) * cs[bj][1] * sa;
#pragma unroll
                    for (int j = 0; j < 4; ++j) { v0[j] = gelu_tanh(v0[j]); v1[j] = gelu_tanh(v1[j]); }
                    *(u32x4*)(rp + bj * 128) = pack8(v0, v1); } }
        } else if (u.kind == 1) {
            EPI_ROWS { const int row = u.pm * 256 + 128 * ai + 16 * m + rt0; bf16_t* rp = BG + (size_t)row * 1024 + (u.pn - 8) * 256 + ct0; const float sa = sa8[ai][m];
                EPI_BJ { *(u32x4*)(rp + bj * 128) = pack8(i2f4(acc[ai][bj][m][0]) * cs[bj][0] * sa, i2f4(acc[ai][bj][m][1]) * cs[bj][1] * sa); } }
        } else if (u.kind == 2) {
            EPI_ROWS { const int row = u.pm * 256 + 128 * ai + 16 * m + rt0; bf16_t* rp = CH + (size_t)row * 1024 + (u.pn - 12) * 128 + ct0; const float sa = sa8[ai][m]; const float s2 = sa * sa;
                *(u32x4*)rp = pack8(i2f4(acc[ai][0][m][0]) * i2f4(acc[ai][1][m][0]) * cs[0][0] * cs[1][0] * s2, i2f4(acc[ai][0][m][1]) * i2f4(acc[ai][1][m][1]) * cs[0][1] * cs[1][1] * s2); }
        } else if (u.kind == 3) {
            EPI_ROWS { const int row = u.pm * 256 + 128 * ai + 16 * m + rt0; bf16_t* rp = Q + (size_t)row * 1024 + (u.pn - 20) * 256 + ct0; const float sa = sa8[ai][m];
                EPI_BJ { *(u32x4*)(rp + bj * 128) = pack8(i2f4(acc[ai][bj][m][0]) * cs[bj][0] * sa, i2f4(acc[ai][bj][m][1]) * cs[bj][1] * sa); } }
        } else {
            const int n = (u.pn - 24) >> 3, cb0 = ((u.pn - 24) & 7) * 256 + ct0;
            EPI_ROWS { const int row = u.pm * 256 + 128 * ai + 16 * m + rt0; unsigned char* rp = SG8 + ((size_t)n * M + row) * 2048 + cb0; const float sa = sa8[ai][m] * -1.44269504f;
                EPI_BJ { const f32x4 t0 = i2f4(acc[ai][bj][m][0]) * (cs[bj][0] * sa), t1 = i2f4(acc[ai][bj][m][1]) * (cs[bj][1] * sa); u32x2 w = {0u, 0u};
#pragma unroll
                    for (int j = 0; j < 4; ++j) {
                        w.x = __builtin_amdgcn_cvt_pk_u8_f32(__builtin_amdgcn_rcpf(__builtin_fmaf(__builtin_amdgcn_exp2f(t0[j]), 0.00390625f, 0.00390625f)) - 0.5f, j, w.x);
                        w.y = __builtin_amdgcn_cvt_pk_u8_f32(__builtin_amdgcn_rcpf(__builtin_fmaf(__builtin_amdgcn_exp2f(t1[j]), 0.00390625f, 0.00390625f)) - 0.5f, j, w.y); }
                    *(u32x2*)(rp + bj * 128) = w; } }
        }
    }
};
struct EpiP3 {
    static constexpr bool CHAIN = true;
    bf16_t* MG; const unsigned char* SG8;
    __device__ __forceinline__ bool operator()(f32x4 (&acc)[2][2][4][2], const Unit& u, int wr, int wc, int fr, int fq) const {
        asm volatile("" : "+v"(fr), "+v"(fq));
        const int rt0 = 64 * wr + fr, ct0 = 32 * wc + 8 * fq; const int n = u.aux;
        const __amdgpu_buffer_rsrc_t rs_ = __builtin_amdgcn_make_buffer_rsrc((void*)SG8, 0, 0x7FFFFFFF, 0x00020000);
        const int vo = rt0 * 2048 + ct0;
        const int nn = n < 2 ? n : 2;
        const int so = (nn * M + u.pm * 256) * 2048 + u.pn * 256;
        const int so2 = n < 2 ? so + M * 2048 : so;
        const float last = n < 2 ? 0.0f : 1.0f;
        u32x2 ga[2][4][2], gb[2][4][2];
        EPI_ROWS { EPI_BJ { const int o_ = (128 * ai + 16 * m) * 2048 + 128 * bj;
            ga[ai][m][bj] = __builtin_bit_cast(u32x2, __builtin_amdgcn_raw_buffer_load_b64(rs_, vo, so + o_, 0)); gb[ai][m][bj] = __builtin_bit_cast(u32x2, __builtin_amdgcn_raw_buffer_load_b64(rs_, vo, so2 + o_, 0)); } }
        EPI_ROWS {
            EPI_BJ {
                float r_[8];
#pragma unroll
                for (int j = 0; j < 4; ++j) {
                    const float a0 = (float)((ga[ai][m][bj].x >> (8 * j)) & 255u) + 0.5f, a1 = (float)((ga[ai][m][bj].y >> (8 * j)) & 255u) + 0.5f;
                    const float b0 = (float)((gb[ai][m][bj].x >> (8 * j)) & 255u) + 0.5f, b1 = (float)((gb[ai][m][bj].y >> (8 * j)) & 255u) + 0.5f;
                    r_[j] = a0 * (last != 0.0f ? (1.0f / 256.0f) : __builtin_amdgcn_rcpf(b0)); r_[4 + j] = a1 * (last != 0.0f ? (1.0f / 256.0f) : __builtin_amdgcn_rcpf(b1)); }
#pragma unroll
                for (int j = 0; j < 4; ++j) { asm volatile("v_mul_f32 %0, %0, %1" : "+v"(acc[ai][bj][m][0][j]) : "v"(r_[j])); asm volatile("v_mul_f32 %0, %0, %1" : "+v"(acc[ai][bj][m][1][j]) : "v"(r_[4 + j])); }
                if (n == 2) { const int row = u.pm * 256 + 128 * ai + 16 * m + rt0, col = u.pn * 256 + ct0 + 128 * bj;
                    *(u32x4*)(MG + (size_t)row * 2048 + col) = pack8(acc[ai][bj][m][0], acc[ai][bj][m][1]);
#pragma unroll
                    for (int j = 0; j < 4; ++j) { asm volatile("v_mul_f32 %0, 0, %0" : "+v"(acc[ai][bj][m][0][j])); asm volatile("v_mul_f32 %0, 0, %0" : "+v"(acc[ai][bj][m][1][j])); } } } }
        return true;
    }
};
struct EpiP4 {
    static constexpr bool CHAIN = false;
    const float* X; float* OUT; bf16_t* X2B; float* SSP;
    __device__ __forceinline__ void operator()(const f32x4 (&acc)[2][2][4][2], const Unit& u, int wr, int wc, int fr, int fq) const {
        asm volatile("" : "+v"(fr), "+v"(fq));
        const int rt0 = 64 * wr + fr, ct0 = 32 * wc + 8 * fq;
#pragma unroll
        for (int ai = 0; ai < 2; ++ai) {
            f32x4 xr[4][2][2];
#pragma unroll
            for (int m = 0; m < 4; ++m) { const int row = u.pm * 256 + 128 * ai + 16 * m + rt0;
                EPI_BJ { const size_t o = (size_t)row * 2048 + u.pn * 256 + ct0 + 128 * bj; xr[m][bj][0] = *(const f32x4*)(X + o); xr[m][bj][1] = *(const f32x4*)(X + o + 4); } }
            __builtin_amdgcn_sched_barrier(0);
#pragma unroll
            for (int m = 0; m < 4; ++m) { const int row = u.pm * 256 + 128 * ai + 16 * m + rt0; float ss = 0.f;
                EPI_BJ { const size_t o = (size_t)row * 2048 + u.pn * 256 + ct0 + 128 * bj;
                    const f32x4 v0 = acc[ai][bj][m][0] + xr[m][bj][0], v1 = acc[ai][bj][m][1] + xr[m][bj][1];
                    *(u32x4*)(X2B + o) = pack8(v0, v1);
                    ss += (v0[0] * v0[0] + v0[1] * v0[1]) + (v0[2] * v0[2] + v0[3] * v0[3]) + (v1[0] * v1[0] + v1[1] * v1[1]) + (v1[2] * v1[2] + v1[3] * v1[3]); }
                ss += __shfl_xor(ss, 16); ss += __shfl_xor(ss, 32);
                if (fq == 0) SSP[(size_t)row * 32 + u.pn * 4 + wc] = ss; }
        }
    }
};
struct EpiBf {
    static constexpr bool CHAIN = false;
    bf16_t* O;
    __device__ __forceinline__ void operator()(const f32x4 (&acc)[2][2][4][2], const Unit& u, int wr, int wc, int fr, int fq) const {
        asm volatile("" : "+v"(fr), "+v"(fq));
        const int rt0 = 64 * wr + fr, ct0 = 32 * wc + 8 * fq;
        EPI_ROWS { const int row = u.pm * 256 + 128 * ai + 16 * m + rt0; bf16_t* rp = O + (size_t)row * 2048 + u.pn * 256 + ct0;
            EPI_BJ { *(u32x4*)(rp + bj * 128) = pack8(acc[ai][bj][m][0], acc[ai][bj][m][1]); } }
    }
};

__device__ __forceinline__ void p0_transpose_item(const float* W, int ldw, int scol0, int k0, bf16_t* WT, int drow0, int K, const float* kscale, LAS float* scr, int lane) {
    {
        const int rr = lane >> 3, cq = (lane & 7) * 4; f32x4 v[8];
#pragma unroll
        for (int i = 0; i < 8; ++i) v[i] = *(const f32x4*)(W + (size_t)(k0 + 8 * i + rr) * ldw + scol0 + cq);
#pragma unroll
        for (int i = 0; i < 8; ++i) { const int kk = 8 * i + rr; const float ks = kscale ? kscale[k0 + kk] : 1.0f;
            scr[kk * 33 + cq] = v[i].x * ks; scr[kk * 33 + cq + 1] = v[i].y * ks; scr[kk * 33 + cq + 2] = v[i].z * ks; scr[kk * 33 + cq + 3] = v[i].w * ks; }
    }
    asm volatile("s_waitcnt lgkmcnt(0)" ::: "memory");
    const int c = lane & 7;
#pragma unroll
    for (int j = 0; j < 4; ++j) { const int n = (lane >> 3) + 8 * j; const LAS float* s = scr + (8 * c) * 33 + n;
        u32x4 o; o.x = pk2(s[0 * 33], s[1 * 33]); o.y = pk2(s[2 * 33], s[3 * 33]); o.z = pk2(s[4 * 33], s[5 * 33]); o.w = pk2(s[6 * 33], s[7 * 33]);
        *(u32x4*)(WT + (size_t)(drow0 + n) * K + k0 + 8 * c) = o; }
    asm volatile("s_waitcnt lgkmcnt(0)" ::: "memory");
}
__device__ __forceinline__ int win_src_col(int j) {
    if (j < 3072 || j >= 5120) return j;
    const int lj = j - 3072, q = lj >> 8, lc = lj & 255, ch = q * 128 + (lc & 127);
    return (lc < 128) ? 3072 + ch : 4096 + ch;
}
__device__ __forceinline__ void row_to_bf16(const float* xrow, bf16_t* orow, const float* g, int lane) {
    const f32x4* xr = (const f32x4*)xrow + lane;
    f32x4 v[8]; float s = 0.f;
#pragma unroll
    for (int j = 0; j < 8; ++j) { v[j] = xr[64 * j]; s += (v[j].x * v[j].x + v[j].y * v[j].y) + (v[j].z * v[j].z + v[j].w * v[j].w); }
    float rs = 1.0f;
    if (g) { rs = __builtin_amdgcn_rsqf(wave_sum(s) * (1.0f / 2048.0f) + EPS); }
    u32x2* o8 = (u32x2*)orow + lane;
#pragma unroll
    for (int j = 0; j < 8; ++j) { f32x4 gg = {1.f, 1.f, 1.f, 1.f}; if (g) gg = ((const f32x4*)g)[64 * j + lane];
        u32x2 w; w.x = pk2(v[j].x * rs * gg.x, v[j].y * rs * gg.y); w.y = pk2(v[j].z * rs * gg.z, v[j].w * rs * gg.w); o8[64 * j] = w; }
}

__device__ __forceinline__ void row_to_fp4u(const float* xrow, unsigned char* wu4, float* scale, int e, int lane) {
    const f32x4* xr = (const f32x4*)xrow + lane;
    f32x4 v[8]; float mx = 0.f;
#pragma unroll
    for (int j = 0; j < 8; ++j) { v[j] = xr[64 * j]; mx = fmaxf(mx, fmaxf(fmaxf(fabsf(v[j].x), fabsf(v[j].y)), fmaxf(fabsf(v[j].z), fabsf(v[j].w)))); }
#pragma unroll
    for (int o = 1; o < 64; o <<= 1) mx = fmaxf(mx, __shfl_xor(mx, o));
    const unsigned scb = pk2(mx * (1.0f / 6.0f), 0.f) & 0xffffu;
    const float scr_ = __uint_as_float(scb << 16);
    const float inv = scr_ > 0.f ? 1.0f / scr_ : 0.f;
    if (lane == 0) *scale = scr_;
#pragma unroll
    for (int j = 0; j < 8; ++j) { unsigned h = 0u;
#pragma unroll
        for (int x = 0; x < 4; ++x) { const float f = v[j][x]; const float a = fabsf(f) * inv;
            const unsigned c = (unsigned)(a > 0.25f) + (unsigned)(a > 0.75f) + (unsigned)(a > 1.25f) + (unsigned)(a > 1.75f) + (unsigned)(a > 2.5f) + (unsigned)(a > 3.5f) + (unsigned)(a > 5.0f);
            h |= (c | ((__float_as_uint(f) >> 28) & 8u)) << (4 * x); }
        *(unsigned short*)(wu4 + ((size_t)j * 16384 + e) * 128 + 2 * lane) = (unsigned short)h; }
}
__device__ __forceinline__ void row_h1(const float* xrow, unsigned char* o8row, float* scale, const float* g, int lane) {
    const f32x4* xr = (const f32x4*)xrow + lane;
    f32x4 v[8]; float s = 0.f;
#pragma unroll
    for (int j = 0; j < 8; ++j) { v[j] = xr[64 * j]; s += (v[j].x * v[j].x + v[j].y * v[j].y) + (v[j].z * v[j].z + v[j].w * v[j].w); }
    const float rs = __builtin_amdgcn_rsqf(wave_sum(s) * (1.0f / 2048.0f) + EPS);
    float mx = 0.f;
#pragma unroll
    for (int j = 0; j < 8; ++j) { const f32x4 gg = ((const f32x4*)g)[64 * j + lane]; v[j] = v[j] * rs * gg; mx = fmaxf(mx, fmaxf(fmaxf(fabsf(v[j].x), fabsf(v[j].y)), fmaxf(fabsf(v[j].z), fabsf(v[j].w)))); }
#pragma unroll
    for (int o = 1; o < 64; o <<= 1) mx = fmaxf(mx, __shfl_xor(mx, o));
    const float inv = mx > 0.f ? 127.0f / mx : 0.f;
    if (lane == 0) *scale = mx * (1.0f / 127.0f);
    unsigned* o4 = (unsigned*)o8row + lane;
#pragma unroll
    for (int j = 0; j < 8; ++j) { const int a = (int)rintf(v[j].x * inv), b = (int)rintf(v[j].y * inv), c = (int)rintf(v[j].z * inv), d = (int)rintf(v[j].w * inv);
        o4[64 * j] = (unsigned)(a & 255) | ((unsigned)(b & 255) << 8) | ((unsigned)(c & 255) << 16) | ((unsigned)(d & 255) << 24); }
}
__device__ __forceinline__ void p0_colmax_item(const float* W, int ldw, int col0, int k0, unsigned* cmx, int lane) {
    const int rr = lane >> 3, cq = (lane & 7) * 4; f32x4 v[8];
#pragma unroll
    for (int i = 0; i < 8; ++i) v[i] = *(const f32x4*)(W + (size_t)(k0 + 8 * i + rr) * ldw + col0 + cq);
    f32x4 mx = {0.f, 0.f, 0.f, 0.f};
#pragma unroll
    for (int i = 0; i < 8; ++i) { mx.x = fmaxf(mx.x, fabsf(v[i].x)); mx.y = fmaxf(mx.y, fabsf(v[i].y)); mx.z = fmaxf(mx.z, fabsf(v[i].z)); mx.w = fmaxf(mx.w, fabsf(v[i].w)); }
#pragma unroll
    for (int o = 8; o < 64; o <<= 1) { mx.x = fmaxf(mx.x, __shfl_xor(mx.x, o)); mx.y = fmaxf(mx.y, __shfl_xor(mx.y, o)); mx.z = fmaxf(mx.z, __shfl_xor(mx.z, o)); mx.w = fmaxf(mx.w, __shfl_xor(mx.w, o)); }
    if (lane < 8) { atomicMax(cmx + cq, __float_as_uint(mx.x)); atomicMax(cmx + cq + 1, __float_as_uint(mx.y)); atomicMax(cmx + cq + 2, __float_as_uint(mx.z)); atomicMax(cmx + cq + 3, __float_as_uint(mx.w)); }
}
__device__ __forceinline__ void p0_transpose8_item(const float* W, int ldw, int scol0, int k0, unsigned char* WT, int drow0, const unsigned* cmx, LAS float* scr, int lane) {
    {   const int rr = lane >> 3, cq = (lane & 7) * 4; f32x4 v[8];
#pragma unroll
        for (int i = 0; i < 8; ++i) v[i] = *(const f32x4*)(W + (size_t)(k0 + 8 * i + rr) * ldw + scol0 + cq);
#pragma unroll
        for (int i = 0; i < 8; ++i) { const int kk = 8 * i + rr; scr[kk * 33 + cq] = v[i].x; scr[kk * 33 + cq + 1] = v[i].y; scr[kk * 33 + cq + 2] = v[i].z; scr[kk * 33 + cq + 3] = v[i].w; }
    }
    asm volatile("s_waitcnt lgkmcnt(0)" ::: "memory");
    const int c = lane & 7;
#pragma unroll
    for (int j = 0; j < 4; ++j) { const int n = (lane >> 3) + 8 * j; const LAS float* sp = scr + (8 * c) * 33 + n;
        const float cm = __uint_as_float(cmx[n]); const float inv = cm > 0.f ? 127.0f / cm : 0.f;
        unsigned p0 = 0u, p1 = 0u;
#pragma unroll
        for (int x = 0; x < 4; ++x) { p0 |= (unsigned)((int)rintf(sp[x * 33] * inv) & 255) << (8 * x); p1 |= (unsigned)((int)rintf(sp[(4 + x) * 33] * inv) & 255) << (8 * x); }
        u32x2 o; o.x = p0; o.y = p1;
        *(u32x2*)(WT + (size_t)(drow0 + n) * 2048 + k0 + 8 * c) = o; }
    asm volatile("s_waitcnt lgkmcnt(0)" ::: "memory");
}

__device__ __forceinline__ void row_to_mx4(const float* xrow, unsigned char* wd4, unsigned char* wds, int e, int lane) {
    float v[32]; float mx = 0.f;
#pragma unroll
    for (int q = 0; q < 8; ++q) { const f32x4 x = *(const f32x4*)(xrow + 32 * lane + 4 * q); v[4 * q] = x.x; v[4 * q + 1] = x.y; v[4 * q + 2] = x.z; v[4 * q + 3] = x.w;
        mx = fmaxf(mx, fmaxf(fmaxf(fabsf(x.x), fabsf(x.y)), fmaxf(fabsf(x.z), fabsf(x.w)))); }
    mx = fmaxf(mx, __shfl_xor(mx, 1)); mx = fmaxf(mx, __shfl_xor(mx, 2)); mx = fmaxf(mx, __shfl_xor(mx, 4));
    const unsigned scb = pk2(mx * (1.0f / 6.0f), 0.f) & 0xffffu;
    const float scr_ = __uint_as_float(scb << 16);
    const float inv = scr_ > 0.f ? 1.0f / scr_ : 0.f;
    unsigned w[4] = {0u, 0u, 0u, 0u};
#pragma unroll
    for (int i = 0; i < 32; ++i) { const float a = fabsf(v[i]) * inv;
        const unsigned c = (unsigned)(a > 0.25f) + (unsigned)(a > 0.75f) + (unsigned)(a > 1.25f) + (unsigned)(a > 1.75f) + (unsigned)(a > 2.5f) + (unsigned)(a > 3.5f) + (unsigned)(a > 5.0f);
        w[i >> 3] |= (c | ((__float_as_uint(v[i]) >> 28) & 8u)) << (4 * (i & 7)); }
    const int sl = lane >> 3, b = lane & 7;
    *(u32x4*)(wd4 + ((size_t)sl * 16384 + e) * 128 + b * 16) = (u32x4){w[0], w[1], w[2], w[3]};
    if (b == 0) *(bf16_t*)(wds + (size_t)e * 16 + 2 * sl) = (bf16_t)scb;
}
struct Args { const float* in[19]; float* out; unsigned char* ws; int ph_lo, ph_hi, li, pad; };

__device__ __forceinline__ void p0_prologue(const Args& A, LAS unsigned char* lds, int vcu, int G, int wave, int lane, int tid) {
    unsigned char* ws = A.ws;
    LAS float* scr = (LAS float*)(lds + wave * 16384);
    const int gw = vcu * NWAVES + wave, NGW = G * NWAVES;
    constexpr int I_WIN = 0, I_KV = 32 * 64, I_WB = 3 * 16 * 64, I_WO = 32 * 64, I_WQ = 32 * 64;
    constexpr int NT = I_WIN + I_KV + I_WB + I_WO + I_WQ;
    for (int it = gw; it < NT; it += NGW) {
        int r = it;
        if (r < I_WIN) { const int kb = r / 160, nb = r % 160; p0_transpose_item(A.in[4], DIN, win_src_col(32 * nb), 64 * kb, (bf16_t*)(ws + WS_WIN), 32 * nb, 2048, nullptr, scr, lane); continue; } r -= I_WIN;
        if (r < I_KV) { const int kb = r / 64, nb = r % 64; p0_transpose_item(A.in[10], 2048, 32 * nb, 64 * kb, (bf16_t*)(ws + WS_WKV), 32 * nb, 2048, nullptr, scr, lane); continue; } r -= I_KV;
        if (r < I_WB) { const int n = r / 1024, rr = r % 1024, kb = rr / 64, nb = rr % 64;
            p0_transpose_item(A.in[11] + (size_t)n * 1024 * 2048, 2048, 32 * nb, 64 * kb, (bf16_t*)(ws + WS_WB) + (size_t)n * 2048 * 1024, 32 * nb, 1024, nullptr, scr, lane); continue; } r -= I_WB;
        if (r < I_WO) { const int kb = r / 64, nb = r % 64; p0_transpose_item(A.in[12], 2048, 32 * nb, 64 * kb, (bf16_t*)(ws + WS_WOUT), 32 * nb, 2048, nullptr, scr, lane); continue; } r -= I_WO;
        { const int kb = r / 64, nb = r % 64; p0_transpose_item(A.in[14], 2048, 32 * nb, 64 * kb, (bf16_t*)(ws + WS_WQ), 32 * nb, 2048, A.in[13], scr, lane); }
    }
    for (int r = gw; r < M + MM + 2 * 16384; r += NGW) {
        if (r < M) row_h1(A.in[0] + (size_t)r * 2048, ws + WS_H8 + (size_t)r * 2048, (float*)(ws + WS_HS) + r, A.in[2], lane);
        else if (r < M + MM) { const int q = r - M; row_to_bf16(A.in[1] + (size_t)q * 2048, (bf16_t*)(ws + WS_MEMN) + (size_t)q * 2048, A.in[3], lane); }
        else if (r < M + MM + 16384) { const int q = r - M - MM; row_to_mx4(A.in[16] + (size_t)q * 2048, ws + WS_WD4, ws + WS_WDS, q, lane);
        }
        else { const int q = r - M - MM - 16384; row_to_fp4u(A.in[17] + (size_t)q * 2048, ws + WS_WU4, (float*)(ws + WS_SCU) + q, q, lane); }
    }
    for (int it = gw; it < 32 * 384; it += NGW) { const int kb = it / 384, nb = it % 384; p0_colmax_item(A.in[4], DIN, win_src_col(32 * nb), 64 * kb, (unsigned*)(ws + WS_CTL + CTL_CMX) + 32 * nb, lane); }
    const int gt = vcu * 512 + tid, NGT = G * 512;
    for (int o = gt; o < 32768; o += NGT) {
        const int ln = o & 63, s = (o >> 6) & 7, kb = (o >> 9) & 3, hp = o >> 11;
        const float* src = A.in[15] + ((size_t)hp * 128 + 32 * kb + (ln & 31)) * 128 + 16 * s + 8 * (ln >> 5);
        const f32x4 a = *(const f32x4*)src, b = *(const f32x4*)(src + 4);
        *(u32x4*)((bf16_t*)(ws + WS_KEYF) + (size_t)o * 8) = pack8(a, b);
    }
    for (int o = gt; o < 16384; o += NGT) {
        const int j0 = (o & 15) * 8, i = (o >> 4) & 127;
        const float* src = A.in[5] + (size_t)o * 8;
        f32x4 a = *(const f32x4*)src, b = *(const f32x4*)(src + 4);
        if ((j0 >> 6) > (i >> 6)) { a = (f32x4){0.f, 0.f, 0.f, 0.f}; b = a; }
        *(u32x4*)((bf16_t*)(ws + WS_WSM) + (size_t)o * 8) = pack8(a, b);
    }
}

__device__ __forceinline__ void p0b_convert(const Args& A, LAS unsigned char* lds, int rank, int nranks, int wave, int lane) {
    unsigned char* ws = A.ws; LAS float* scr = (LAS float*)(lds + wave * 16384);
    const int gw = rank * NWAVES + wave, NGW = nranks * NWAVES;
    for (int it = gw; it < 32 * 384; it += NGW) { const int kb = it / 384, nb = it % 384;
        p0_transpose8_item(A.in[4], DIN, win_src_col(32 * nb), 64 * kb, ws + WS_W8, 32 * nb, (const unsigned*)(ws + WS_CTL + CTL_CMX) + 32 * nb, scr, lane); }
}

__device__ __forceinline__ void p2_gmlp_block(const Args& A, LAS unsigned char* lds, int blk, int wave, int lane, int tid) {
    unsigned char* ws = A.ws;
    const bf16_t* GA = (const bf16_t*)(ws + WS_GA); bf16_t* YA = (bf16_t*)(ws + WS_YA); const bf16_t* WSM = (const bf16_t*)(ws + WS_WSM);
    const float *b_s = A.in[6], *ln_g = A.in[7], *ln_b = A.in[8];
    LAS float* stat = (LAS float*)lds;
    LAS bf16_t* vT = (LAS bf16_t*)(lds + 1024);
    const int r0 = blk * 128, hh = lane >> 5, r = lane & 31;
    for (int r4 = 0; r4 < 16; r4 += 4) {
        u32x4 a[4], b[4];
#pragma unroll
        for (int k = 0; k < 4; ++k) { const bf16_t* vp = GA + (size_t)(r0 + wave * 16 + r4 + k) * 2048 + 1024 + lane * 8; a[k] = *(const u32x4*)vp; b[k] = *(const u32x4*)(vp + 512); }
#pragma unroll
        for (int k = 0; k < 4; ++k) { float s = 0.f, q = 0.f;
#pragma unroll
            for (int j = 0; j < 4; ++j) { const float x0 = bf_lo(a[k][j]), x1 = bf_hi(a[k][j]), y0 = bf_lo(b[k][j]), y1 = bf_hi(b[k][j]); s += (x0 + x1) + (y0 + y1); q += (x0 * x0 + x1 * x1) + (y0 * y0 + y1 * y1); }
            s = wave_sum(s); q = wave_sum(q);
            const float mean = s * (1.0f / 1024.0f), var = q * (1.0f / 1024.0f) - mean * mean;
            if (lane == 0) { stat[2 * (wave * 16 + r4 + k)] = mean; stat[2 * (wave * 16 + r4 + k) + 1] = __builtin_amdgcn_rsqf(var + EPS); } }
    }
    __syncthreads();
    constexpr int VTB = 128 * 136;
#pragma unroll 1
    for (int g0 = 0; g0 < 8; g0 += 3) {
        const int ng = (8 - g0) < 3 ? (8 - g0) : 3;
        {
            const int j = tid >> 2, cc = (tid & 3) * 32; const float mu = stat[2 * j], rstd = stat[2 * j + 1];
            u32x4 av[3][4];
#pragma unroll
            for (int gl = 0; gl < 3; ++gl) if (gl < ng) { const bf16_t* vp = GA + (size_t)(r0 + j) * 2048 + 1024 + (g0 + gl) * 128 + cc;
#pragma unroll
                for (int k4 = 0; k4 < 4; ++k4) av[gl][k4] = *(const u32x4*)(vp + 8 * k4); }
#pragma unroll
            for (int gl = 0; gl < 3; ++gl) if (gl < ng) { LAS bf16_t* vt = vT + gl * VTB;
#pragma unroll
                for (int k4 = 0; k4 < 4; ++k4) { const u32x4 a = av[gl][k4]; const int ch = (g0 + gl) * 128 + cc + 8 * k4;
                    const f32x4 gg0 = *(const f32x4*)(ln_g + ch), gg1 = *(const f32x4*)(ln_g + ch + 4), bb0 = *(const f32x4*)(ln_b + ch), bb1 = *(const f32x4*)(ln_b + ch + 4);
#pragma unroll
                    for (int x = 0; x < 4; ++x) { const float lo = (bf_lo(a[x]) - mu) * rstd * (x < 2 ? gg0[2 * x] : gg1[2 * x - 4]) + (x < 2 ? bb0[2 * x] : bb1[2 * x - 4]);
                        const float hi = (bf_hi(a[x]) - mu) * rstd * (x < 2 ? gg0[2 * x + 1] : gg1[2 * x - 3]) + (x < 2 ? bb0[2 * x + 1] : bb1[2 * x - 3]);
                        const unsigned p = pk2(lo, hi);
                        vt[(cc + 8 * k4 + 2 * x) * 136 + j] = (bf16_t)(p & 0xffffu); vt[(cc + 8 * k4 + 2 * x + 1) * 136 + j] = (bf16_t)(p >> 16); } } }
        }
        __syncthreads();
#pragma unroll 1
        for (int gl = 0; gl < ng; ++gl) {
            const int grp = g0 + gl; const LAS bf16_t* vt = vT + gl * VTB;
            const int cb = wave >> 1, ib0 = 2 * (wave & 1);
            f32x16 acc[2];
#pragma unroll
            for (int q = 0; q < 2; ++q)
#pragma unroll
                for (int e = 0; e < 16; ++e) acc[q][e] = 0.f;
            u32x2 uu8[2][4]; float bias2[2];
#pragma unroll
            for (int q = 0; q < 2; ++q) { const int i = (ib0 + q) * 32 + r, row = r0 + i; bias2[q] = b_s[grp * 128 + i];
#pragma unroll
                for (int g4 = 0; g4 < 4; ++g4) uu8[q][g4] = *(const u32x2*)(GA + (size_t)row * 2048 + grp * 128 + cb * 32 + 8 * g4 + 4 * hh); }
#pragma unroll
            for (int s = 0; s < 8; ++s) {
                const bf16x8 a = *(const LAS bf16x8*)(vt + (cb * 32 + r) * 136 + 16 * s + 8 * hh);
#pragma unroll
                for (int q = 0; q < 2; ++q) { const bf16x8 b = *(const bf16x8*)(WSM + ((size_t)grp * 128 + (ib0 + q) * 32 + r) * 128 + 16 * s + 8 * hh); acc[q] = MFMA32(a, b, acc[q]); }
            }
#pragma unroll
            for (int q = 0; q < 2; ++q) { const int i = (ib0 + q) * 32 + r, row = r0 + i; const float bias = bias2[q];
#pragma unroll
                for (int g4 = 0; g4 < 4; ++g4) { const int col = grp * 128 + cb * 32 + 8 * g4 + 4 * hh;
                    const u32x2 uu = uu8[q][g4];
                    u32x2 w; w.x = pk2((acc[q][4 * g4] + bias) * bf_lo(uu.x), (acc[q][4 * g4 + 1] + bias) * bf_hi(uu.x));
                    w.y = pk2((acc[q][4 * g4 + 2] + bias) * bf_lo(uu.y), (acc[q][4 * g4 + 3] + bias) * bf_hi(uu.y));
                    *(u32x2*)(YA + (size_t)row * 1024 + col) = w; } }
        }
        __syncthreads();
    }
}
__device__ __forceinline__ void p2_conv(const Args& A, int vcu, int G, int tid) {
    unsigned char* ws = A.ws; bf16_t* BG = (bf16_t*)(ws + WS_BG); const bf16_t* CH = (const bf16_t*)(ws + WS_CH); const float* cw = A.in[9];
    const int stride = G * 512;
    const int c = ((vcu * 512 + tid) & 127) * 8;
    const f32x4 w0a = *(const f32x4*)(cw + c), w0b = *(const f32x4*)(cw + c + 4), w1a = *(const f32x4*)(cw + 1024 + c), w1b = *(const f32x4*)(cw + 1024 + c + 4), w2a = *(const f32x4*)(cw + 2048 + c), w2b = *(const f32x4*)(cw + 2048 + c + 4);
    for (int idx0 = vcu * 512 + tid; idx0 < M * 128; idx0 += 4 * stride) {
        u32x4 c0[4], c1[4], c2[4], bg[4];
#pragma unroll
        for (int k = 0; k < 4; ++k) { const int idx = idx0 + k * stride; const bool ok = idx < M * 128; const int t = ok ? idx >> 7 : 0, s = t & (SEQ - 1);
            const size_t o = (size_t)t * 1024 + c; const u32x4 z = {0u, 0u, 0u, 0u};
            c0[k] = *(const u32x4*)(CH + o); c1[k] = s >= 1 ? *(const u32x4*)(CH + o - 1024) : z; c2[k] = s >= 2 ? *(const u32x4*)(CH + o - 2048) : z; bg[k] = *(const u32x4*)(BG + o); }
#pragma unroll
        for (int k = 0; k < 4; ++k) { const int idx = idx0 + k * stride; if (idx < M * 128) { const int t = idx >> 7;
            u32x4 y;
#pragma unroll
            for (int x = 0; x < 4; ++x) { const float wl0 = x < 2 ? w0a[2 * x] : w0b[2 * x - 4], wh0 = x < 2 ? w0a[2 * x + 1] : w0b[2 * x - 3], wl1 = x < 2 ? w1a[2 * x] : w1b[2 * x - 4], wh1 = x < 2 ? w1a[2 * x + 1] : w1b[2 * x - 3], wl2 = x < 2 ? w2a[2 * x] : w2b[2 * x - 4], wh2 = x < 2 ? w2a[2 * x + 1] : w2b[2 * x - 3];
                const float lo = bf_lo(bg[k][x]) * (wl0 * bf_lo(c2[k][x]) + wl1 * bf_lo(c1[k][x]) + wl2 * bf_lo(c0[k][x]));
                const float hi = bf_hi(bg[k][x]) * (wh0 * bf_hi(c2[k][x]) + wh1 * bf_hi(c1[k][x]) + wh2 * bf_hi(c0[k][x]));
                y[x] = pk2(lo, hi); }
            *(u32x4*)(BG + (size_t)t * 1024 + c) = y; } }
    }
}
__device__ __forceinline__ void p2_attn_copy(LAS unsigned char* lds, const unsigned char* src, int tid) {
    const u32x4* s4 = (const u32x4*)src + tid;
#pragma unroll
    for (int hlf = 0; hlf < 2; ++hlf) {
        u32x4 v[8];
#pragma unroll
        for (int i = 0; i < 8; ++i) v[i] = s4[(hlf * 8 + i) * 512];
#pragma unroll
        for (int i = 0; i < 8; ++i) *(LAS u32x4*)(lds + (size_t)((hlf * 8 + i) * 512 + tid) * 16) = v[i];
        asm volatile("" ::: "memory");
    }
}
__device__ __forceinline__ void p2_attn_unit(const Args& A, LAS unsigned char* lds, int b, int h, int q0, int lane, int tid) {
    asm volatile("" : "+v"(lane), "+v"(tid));
    unsigned char* ws = A.ws; const bf16_t* Q = (const bf16_t*)(ws + WS_Q); bf16_t* YC = (bf16_t*)(ws + WS_YC);
    const unsigned char* KFg = ws + WS_KF + (size_t)(b * 4 + h) * 131072; const unsigned char* VFg = ws + WS_VF + (size_t)(b * 4 + h) * 131072;
    const LAS bf16x8* FL = (const LAS bf16x8*)lds + lane; const LAS bf16x8* FH = FL + 4096;
    const int r = lane & 31, hh = lane >> 5;
    const size_t trow = (size_t)(b * SEQ + q0 + r) * 1024 + h * 256;
    __syncthreads();
    p2_attn_copy(lds, KFg, tid);
    __syncthreads();
    f32x16 acc[8];
#pragma unroll
    for (int kb = 0; kb < 8; ++kb)
#pragma unroll
        for (int e = 0; e < 16; ++e) acc[kb][e] = 0.f;
#pragma unroll 2
    for (int s = 0; s < 16; ++s) {
        const bf16x8 qf = *(const bf16x8*)(Q + trow + 16 * s + 8 * hh);
#pragma unroll
        for (int kb = 0; kb < 8; ++kb) acc[kb] = MFMA32((kb < 4 ? FL : FH)[((kb & 3) * 16 + s) * 64], qf, acc[kb]);
    }
    constexpr float C1 = 0.0625f * 1.44269504f;
    float mx = -3.0e38f;
#pragma unroll
    for (int kb = 0; kb < 8; ++kb)
#pragma unroll
        for (int e = 0; e < 16; ++e) mx = fmaxf(mx, acc[kb][e]);
    mx = fmaxf(mx, __shfl_xor(mx, 32));
    const float mc = mx * C1; float l = 0.f;
#pragma unroll
    for (int kb = 0; kb < 8; ++kb)
#pragma unroll
        for (int e = 0; e < 16; ++e) { const float p = __builtin_amdgcn_exp2f(acc[kb][e] * C1 - mc); acc[kb][e] = p; l += p; }
    l += __shfl_xor(l, 32);
    bf16x8 pf[16];
#pragma unroll
    for (int kb = 0; kb < 8; ++kb)
#pragma unroll
        for (int s = 0; s < 2; ++s) { u32x4 w; w.x = pk2(acc[kb][8 * s], acc[kb][8 * s + 1]); w.y = pk2(acc[kb][8 * s + 2], acc[kb][8 * s + 3]); w.z = pk2(acc[kb][8 * s + 4], acc[kb][8 * s + 5]); w.w = pk2(acc[kb][8 * s + 6], acc[kb][8 * s + 7]);
            pf[kb * 2 + s] = __builtin_bit_cast(bf16x8, w); }
    const float inv = 1.0f / l;
    __syncthreads();
    p2_attn_copy(lds, VFg, tid);
    __syncthreads();
    int l2 = lane; asm volatile("" : "+v"(l2));
    const size_t orow = (size_t)(b * SEQ + q0 + (l2 & 31)) * 1024 + h * 256 + 4 * (l2 >> 5);
#pragma unroll 1
    for (int db = 0; db < 8; ++db) {
        f32x16 od;
#pragma unroll
        for (int e = 0; e < 16; ++e) od[e] = 0.f;
#pragma unroll
        for (int ks = 0; ks < 16; ++ks) od = MFMA32(FL[(db * 16 + ks) * 64], pf[ks], od);
#pragma unroll
        for (int g4 = 0; g4 < 4; ++g4) { u32x2 w; w.x = pk2(od[4 * g4] * inv, od[4 * g4 + 1] * inv); w.y = pk2(od[4 * g4 + 2] * inv, od[4 * g4 + 3] * inv);
            *(u32x2*)(YC + orow + 32 * db + 8 * g4) = w; }
    }
}

__device__ __forceinline__ unsigned ord_u(float f) { const unsigned b = __float_as_uint(f); return b ^ ((unsigned)((int)b >> 31) | 0x80000000u); }
__device__ __forceinline__ float unord_f(unsigned u) { return __uint_as_float(u ^ ((u & 0x80000000u) ? 0x80000000u : 0xFFFFFFFFu)); }
#define TOPK_INS(L, xx) do { unsigned _x = (xx); _Pragma("unroll") for (int _j = 0; _j < 16; ++_j) { const unsigned _hi = L[_j] > _x ? L[_j] : _x; _x = L[_j] > _x ? _x : L[_j]; L[_j] = _hi; } } while (0)
__device__ __forceinline__ void bitonic_sort16_desc(u32x16& v) {
#pragma unroll
    for (int k = 2; k <= 16; k <<= 1)
#pragma unroll
        for (int j = k >> 1; j > 0; j >>= 1)
#pragma unroll
            for (int i = 0; i < 16; ++i) { const int l = i ^ j; if (l > i) { const unsigned a = v[i], b = v[l], hi = a > b ? a : b, lo = a > b ? b : a; const bool desc = ((i & k) == 0); v[i] = desc ? hi : lo; v[l] = desc ? lo : hi; } }
}
__device__ __forceinline__ void bitonic_merge16_desc(u32x16& v) {
#pragma unroll
    for (int j = 8; j > 0; j >>= 1)
#pragma unroll
        for (int i = 0; i < 16; ++i) { const int l = i ^ j; if (l > i) { const unsigned a = v[i], b = v[l]; v[i] = a > b ? a : b; v[l] = a > b ? b : a; } }
}
__device__ __forceinline__ void top16_merge(u32x16& A, const u32x16 B) {
#pragma unroll
    for (int i = 0; i < 16; ++i) { const unsigned a = A[i], b = B[15 - i]; A[i] = a > b ? a : b; }
    bitonic_merge16_desc(A);
}
__device__ __forceinline__ unsigned sel16(const u32x16 T, unsigned i) {
    unsigned a[8], b[4], c[2];
    const unsigned m0 = 0u - (i & 1u), m1 = 0u - ((i >> 1) & 1u), m2 = 0u - ((i >> 2) & 1u), m3 = 0u - ((i >> 3) & 1u);
#pragma unroll
    for (int q = 0; q < 8; ++q) a[q] = (T[2 * q + 1] & m0) | (T[2 * q] & ~m0);
#pragma unroll
    for (int q = 0; q < 4; ++q) b[q] = (a[2 * q + 1] & m1) | (a[2 * q] & ~m1);
#pragma unroll
    for (int q = 0; q < 2; ++q) c[q] = (b[2 * q + 1] & m2) | (b[2 * q] & ~m2);
    return (c[1] & m3) | (c[0] & ~m3);
}
__device__ __forceinline__ void p6_half(const LAS unsigned char* kl, const bf16_t* pq, int lane, u32x16& L) {
    const int hh = lane >> 5;
    bf16x8 qf[8];
#pragma unroll
    for (int s = 0; s < 8; ++s) qf[s] = *(const bf16x8*)(pq + 16 * s + 8 * hh);
    f32x16 acc[4];
#pragma unroll
    for (int kb = 0; kb < 4; ++kb) {
#pragma unroll
        for (int e = 0; e < 16; ++e) acc[kb][e] = 0.f;
#pragma unroll
        for (int s = 0; s < 8; ++s) acc[kb] = MFMA32(*(const LAS bf16x8*)(kl + ((kb * 8 + s) * 64 + lane) * 16), qf[s], acc[kb]);
    }
    const unsigned nh4 = hh ? 0u : 4u;
    u32x16 X[4];
#pragma unroll
    for (int kb = 0; kb < 4; ++kb) {
#pragma unroll
        for (int e = 0; e < 16; ++e) {
            const unsigned kc = (unsigned)(32 * kb + (e & 3) + 8 * (e >> 2));
            X[kb][e] = (ord_u(acc[kb][e]) & ~127u) | ((~kc) & 0x7Bu) | nh4;
        }
        bitonic_sort16_desc(X[kb]);
    }
    top16_merge(X[0], X[1]); top16_merge(X[2], X[3]); top16_merge(X[0], X[2]);
    L = X[0];
    u32x16 P;
#pragma unroll
    for (int j = 0; j < 16; ++j) P[j] = (unsigned)__shfl_xor((int)L[j], 32);
    top16_merge(L, P);
}
__device__ __forceinline__ void p6_tile(const Args& A, const LAS unsigned char* keys_lds, int head, int t0, int lane) {
    unsigned char* ws = A.ws;
    const int r = lane & 31, hh = lane >> 5, t = t0 + r;
    const bf16_t* pq = (const bf16_t*)(ws + WS_PQ) + (size_t)t * 2048 + head * 256;
    u32x16 L1, L2;
    p6_half(keys_lds, pq, lane, L1);
    p6_half(keys_lds + 32768, pq + 128, lane, L2);
    f32x16 sa, sb;
#pragma unroll
    for (int j = 0; j < 16; ++j) { sa[j] = unord_f(L1[j] & ~127u); sb[j] = unord_f(L2[j] & ~127u); }
    u32x16 CG[4];
#pragma unroll
    for (int q = 0; q < 4; ++q)
#pragma unroll
        for (int j = 0; j < 16; ++j) CG[q][j] = 0u;
    {
        int cnt = 0;
#pragma unroll
        for (int i = 0; i < 16; ++i)
#pragma unroll
            for (int j = 0; j < 16; ++j) if ((i + 1) * (j + 1) <= 16) { CG[cnt >> 4][cnt & 15] = (ord_u(sa[i] + sb[j]) & ~255u) | (unsigned)(255 - (i * 16 + j)); ++cnt; }
    }
#pragma unroll
    for (int q = 0; q < 4; ++q) bitonic_sort16_desc(CG[q]);
    top16_merge(CG[0], CG[1]); top16_merge(CG[2], CG[3]); top16_merge(CG[0], CG[2]);
    const u32x16 C = CG[0];
    const f32x4* sp = (const f32x4*)((const float*)(ws + WS_SSP) + (size_t)t * 32);
    float ss = 0.f;
#pragma unroll
    for (int j = 0; j < 8; ++j) { const f32x4 v = sp[j]; ss += (v.x + v.y) + (v.z + v.w); }
    const float rs = __builtin_amdgcn_rsqf(ss * (1.0f / 2048.0f) + EPS) * 1.44269504f;
    if (head == 0 && hh == 0) ((float*)(ws + WS_RS))[t] = rs * (1.0f / 1.44269504f);
    f32x16 ev; u32x16 ei; float den = 0.f; const float s0 = unord_f(C[0] & ~255u);
#pragma unroll
    for (int k = 0; k < 16; ++k) {
        const unsigned code = 255u - (C[k] & 255u);
        const float sv = unord_f(C[k] & ~255u);
        ev[k] = __builtin_amdgcn_exp2f((sv - s0) * rs); den += ev[k];
        const unsigned i1 = 127u - (sel16(L1, code >> 4) & 127u), i2 = 127u - (sel16(L2, code & 15u) & 127u);
        ei[k] = i1 * 128u + i2;
    }
    const float inv = 1.0f / den;
    u32x4 oi[2]; f32x4 og[2];
#pragma unroll
    for (int j = 0; j < 8; ++j) { oi[j >> 2][j & 3] = hh ? ei[8 + j] : ei[j]; og[j >> 2][j & 3] = (hh ? ev[8 + j] : ev[j]) * inv; }
    const size_t o = (size_t)t * 128 + head * 16 + 8 * hh;
    u32x4* ip = (u32x4*)((unsigned*)(ws + WS_IDX) + o); ip[0] = oi[0]; ip[1] = oi[1];
    f32x4* gp = (f32x4*)((float*)(ws + WS_GW) + o); gp[0] = og[0]; gp[1] = og[1];
}

__device__ __forceinline__ float dpp_sum(float v) {
    int x = (int)__float_as_uint(v);
    v += __uint_as_float((unsigned)__builtin_amdgcn_update_dpp(0, x, 0xB1, 0xF, 0xF, false)); x = (int)__float_as_uint(v);
    v += __uint_as_float((unsigned)__builtin_amdgcn_update_dpp(0, x, 0x4E, 0xF, 0xF, false)); x = (int)__float_as_uint(v);
    v += __uint_as_float((unsigned)__builtin_amdgcn_update_dpp(0, x, 0x141, 0xF, 0xF, false)); x = (int)__float_as_uint(v);
    v += __uint_as_float((unsigned)__builtin_amdgcn_update_dpp(0, x, 0x140, 0xF, 0xF, false)); x = (int)__float_as_uint(v);
    v += __uint_as_float((unsigned)__builtin_amdgcn_update_dpp(0, x, 0x142, 0xA, 0xF, false)); x = (int)__float_as_uint(v);
    v += __uint_as_float((unsigned)__builtin_amdgcn_update_dpp(0, x, 0x143, 0xC, 0xF, false));
    return __uint_as_float((unsigned)__builtin_amdgcn_readlane((int)__float_as_uint(v), 63));
}
constexpr int P7_TB = 64;
__device__ __forceinline__ i32x8 p7x_a8(const u32x4 a) { return (i32x8){(int)a.x, (int)a.y, (int)a.z, (int)a.w, 0, 0, 0, 0}; }
__device__ __forceinline__ void p7x_wave(const Args& A, LAS unsigned char* lds, int wave, int lane_, int qset) {
    unsigned char* ws = A.ws;
    const __amdgpu_buffer_rsrc_t rsrc = __builtin_amdgcn_make_buffer_rsrc((void*)ws, 0, 0x7FFFFFFF, 0x00020000);
    int lane = lane_; asm volatile("" : "+v"(lane));
    LAS unsigned char* rowbuf = lds + wave * 16384;
    LAS unsigned char* hx = lds + LDSCTL_OFF + 4096 + wave * 512;
    const int r = lane & 15, g = lane >> 4, l3 = lane >> 3;
    const int fr = ((r >> 1) & 3) | ((r >> 3) << 2);
    const int rd0 = r * 128 + ((g ^ fr) << 4), rd1 = r * 128 + (((4 + g) ^ fr) << 4);
    const int f0 = (l3 >> 1) & 3;
    const int pc0 = ((lane & 7) ^ f0) << 4, pc1 = ((lane & 7) ^ (f0 | 4)) << 4;
    const int vo_a = l3 * 64, vo_x = lane * 8, vo_p = (16 * (r & 7) + 4 * g) * 2;
    int scg[8];
#pragma unroll
    for (int G_ = 0; G_ < 8; ++G_) scg[G_] = ((r & 7) == G_) ? 0x7F7F7F7F : 0;
    const int hb = (g << 4);
    unsigned* Q = (unsigned*)(ws + WS_CTL + CTL_P7Q) + qset * 512;
    const int xs = (int)(xb_xcc_id() & 7u);
#pragma unroll 1
    for (int k = 0; k < 8; ++k) {
        const int s = (xs + k) & 7;
        const f32x4 gs = *(const f32x4*)(A.in[13] + 256 * s + 4 * lane);
        const int so_w = (int)WS_WD4 + s * (16384 * 128);
#pragma unroll 1
        for (;;) {
            unsigned blk = 0u; if (lane == 0) blk = xb_add(Q + s * 64, 1u);
            blk = (unsigned)__builtin_amdgcn_readfirstlane((int)blk);
            if (blk >= (unsigned)(M / P7_TB)) break;
            const int t0 = (int)blk * P7_TB;
            u32x4 ea[4]; u32x2 xv; float rsv; i32x8 B0, B1, B2, B3;
#define P7X_IDX(tt) do { const int t_ = (tt); const int so_ = (int)WS_IDX + t_ * 512; \
            xv = __builtin_bit_cast(u32x2, __builtin_amdgcn_raw_buffer_load_b64(rsrc, vo_x, (int)WS_GA + t_ * 4096 + s * 512, 0)); \
            rsv = __uint_as_float((unsigned)__builtin_amdgcn_raw_buffer_load_b32(rsrc, 0, (int)WS_RS + t_ * 4, 0)); __builtin_amdgcn_sched_barrier(0); \
            _Pragma("unroll") for (int q_ = 0; q_ < 4; ++q_) ea[q_] = __builtin_bit_cast(u32x4, __builtin_amdgcn_raw_buffer_load_b128(rsrc, vo_a + 16 * q_, so_, 0)); } while (0)
#define P7X_HX() do { const float h0_ = bf_lo(xv.x) * rsv * gs.x, h1_ = bf_hi(xv.x) * rsv * gs.y, h2_ = bf_lo(xv.y) * rsv * gs.z, h3_ = bf_hi(xv.y) * rsv * gs.w; \
            int hi_ = __builtin_amdgcn_cvt_pk_fp8_f32(h0_, h1_, 0, false); hi_ = __builtin_amdgcn_cvt_pk_fp8_f32(h2_, h3_, hi_, true); \
            int lo_ = __builtin_amdgcn_cvt_pk_fp8_f32(h0_ - __builtin_amdgcn_cvt_f32_fp8(hi_, 0), h1_ - __builtin_amdgcn_cvt_f32_fp8(hi_, 1), 0, false); \
            lo_ = __builtin_amdgcn_cvt_pk_fp8_f32(h2_ - __builtin_amdgcn_cvt_f32_fp8(hi_, 2), h3_ - __builtin_amdgcn_cvt_f32_fp8(hi_, 3), lo_, true); \
            *(LAS int*)(hx + 4 * lane) = hi_; *(LAS int*)(hx + 256 + 4 * lane) = lo_; } while (0)
#define P7X_BLD() do { const u32x4 b0_ = *(const LAS u32x4*)(hx + hb), b1_ = *(const LAS u32x4*)(hx + hb + 64), b2_ = *(const LAS u32x4*)(hx + hb + 128), b3_ = *(const LAS u32x4*)(hx + hb + 192); \
            B0 = (i32x8){(int)b0_.x, (int)b0_.y, (int)b0_.z, (int)b0_.w, (int)b1_.x, (int)b1_.y, (int)b1_.z, (int)b1_.w}; \
            B1 = (i32x8){(int)b2_.x, (int)b2_.y, (int)b2_.z, (int)b2_.w, (int)b3_.x, (int)b3_.y, (int)b3_.z, (int)b3_.w}; \
            const u32x4 c0_ = *(const LAS u32x4*)(hx + hb + 256), c1_ = *(const LAS u32x4*)(hx + hb + 320), c2_ = *(const LAS u32x4*)(hx + hb + 384), c3_ = *(const LAS u32x4*)(hx + hb + 448); \
            B2 = (i32x8){(int)c0_.x, (int)c0_.y, (int)c0_.z, (int)c0_.w, (int)c1_.x, (int)c1_.y, (int)c1_.z, (int)c1_.w}; \
            B3 = (i32x8){(int)c2_.x, (int)c2_.y, (int)c2_.z, (int)c2_.w, (int)c3_.x, (int)c3_.y, (int)c3_.z, (int)c3_.w}; } while (0)
#define P7X_DMA() do { _Pragma("unroll") for (int i = 0; i < 16; ++i) __builtin_amdgcn_raw_ptr_buffer_load_lds(rsrc, (LAS void*)(rowbuf + i * 1024), 16, (int)(ea[i >> 2][i & 3] * 128u) + ((i & 1) ? pc1 : pc0), so_w, 0, 0); } while (0)
            P7X_IDX(t0);
            P7X_HX(); P7X_BLD();
            P7X_DMA();
            P7X_IDX(t0 + 1);
            __builtin_amdgcn_raw_buffer_store_b32(0u, rsrc, lane * 4, (int)WS_CTL + 950 * 1024, 0);
#pragma unroll 1
            for (int v = 0; v < P7_TB; ++v) {
                if (v == 0) asm volatile("s_waitcnt vmcnt(0)" ::: "memory"); else asm volatile("s_waitcnt vmcnt(1)" ::: "memory");
                if (v + 1 < P7_TB) P7X_HX();
                f32x4 acc0 = {0.f, 0.f, 0.f, 0.f}, acc1 = {0.f, 0.f, 0.f, 0.f};
#pragma unroll
                for (int G_ = 0; G_ < 8; ++G_) {
                    const u32x4 a0 = *(const LAS u32x4*)(rowbuf + G_ * 2048 + rd0), a1 = *(const LAS u32x4*)(rowbuf + G_ * 2048 + rd1);
                    if (G_ & 1) {
                        acc1 = __builtin_amdgcn_mfma_scale_f32_16x16x128_f8f6f4(p7x_a8(a0), B0, acc1, 4, 0, 0, 0x7F7F7F7F, 0, scg[G_]); acc1 = __builtin_amdgcn_mfma_scale_f32_16x16x128_f8f6f4(p7x_a8(a1), B1, acc1, 4, 0, 0, 0x7F7F7F7F, 0, scg[G_]);
                        acc1 = __builtin_amdgcn_mfma_scale_f32_16x16x128_f8f6f4(p7x_a8(a0), B2, acc1, 4, 0, 0, 0x7F7F7F7F, 0, scg[G_]); acc1 = __builtin_amdgcn_mfma_scale_f32_16x16x128_f8f6f4(p7x_a8(a1), B3, acc1, 4, 0, 0, 0x7F7F7F7F, 0, scg[G_]);
                    } else {
                        acc0 = __builtin_amdgcn_mfma_scale_f32_16x16x128_f8f6f4(p7x_a8(a0), B0, acc0, 4, 0, 0, 0x7F7F7F7F, 0, scg[G_]); acc0 = __builtin_amdgcn_mfma_scale_f32_16x16x128_f8f6f4(p7x_a8(a1), B1, acc0, 4, 0, 0, 0x7F7F7F7F, 0, scg[G_]);
                        acc0 = __builtin_amdgcn_mfma_scale_f32_16x16x128_f8f6f4(p7x_a8(a0), B2, acc0, 4, 0, 0, 0x7F7F7F7F, 0, scg[G_]); acc0 = __builtin_amdgcn_mfma_scale_f32_16x16x128_f8f6f4(p7x_a8(a1), B3, acc0, 4, 0, 0, 0x7F7F7F7F, 0, scg[G_]);
                    }
                }
                if (v + 1 < P7_TB) { P7X_BLD(); asm volatile("s_waitcnt lgkmcnt(0)" ::: "memory"); P7X_DMA(); }
                { const int vn = v + 2 < P7_TB ? v + 2 : P7_TB - 1; P7X_IDX(t0 + vn); }
                const int so_p = (int)WS_PART + ((s * M + t0 + v) * 128) * 2;
                u32x2 o_; o_.x = pk2(acc0[0] + acc1[0], acc0[1] + acc1[1]); o_.y = pk2(acc0[2] + acc1[2], acc0[3] + acc1[3]);
                __builtin_amdgcn_raw_buffer_store_b64(o_, rsrc, vo_p, so_p, 0);
            }
            asm volatile("s_waitcnt vmcnt(0)" ::: "memory");
#undef P7X_IDX
#undef P7X_HX
#undef P7X_BLD
#undef P7X_DMA
        }
    }
}
template <int NT>
__device__ __forceinline__ void p7y_tokens(const Args& A, int tb, int tstride, int lane) {
    unsigned char* ws = A.ws;
    const float* SCU = (const float*)(ws + WS_SCU);
    int jj[2];
#pragma unroll
    for (int x = 0; x < 2; ++x) { const int R_ = 2 * lane + x; jj[x] = 16 * (R_ & 7) + (R_ >> 3); }
    int iv0[NT], iv1[NT]; float gw0[NT], gw1[NT]; unsigned pw[NT][8];
#pragma unroll
    for (int n = 0; n < NT; ++n) { const int t = tb + n * tstride;
        const int* ip = (const int*)(ws + WS_IDX) + (size_t)t * 128; const float* gp = (const float*)(ws + WS_GW) + (size_t)t * 128;
        iv0[n] = ip[jj[0]]; iv1[n] = ip[jj[1]]; gw0[n] = gp[jj[0]]; gw1[n] = gp[jj[1]];
        const unsigned* pp = (const unsigned*)(ws + WS_PART) + (size_t)t * 64 + lane;
#pragma unroll
        for (int s = 0; s < 8; ++s) pw[n][s] = pp[(size_t)s * M * 64]; }
    u32x4 sa[NT], sb[NT]; float su0[NT], su1[NT];
#pragma unroll
    for (int n = 0; n < NT; ++n) { sa[n] = *(const u32x4*)(ws + WS_WDS + (size_t)iv0[n] * 16); sb[n] = *(const u32x4*)(ws + WS_WDS + (size_t)iv1[n] * 16); su0[n] = SCU[iv0[n]]; su1[n] = SCU[iv1[n]]; }
#pragma unroll
    for (int n = 0; n < NT; ++n) { const int t = tb + n * tstride;
        float dv0 = 0.f, dv1 = 0.f;
#pragma unroll
        for (int s = 0; s < 8; ++s) { const unsigned a_ = sa[n][s >> 1], b_ = sb[n][s >> 1];
            dv0 += bf_lo(pw[n][s]) * ((s & 1) ? bf_hi(a_) : bf_lo(a_)); dv1 += bf_hi(pw[n][s]) * ((s & 1) ? bf_hi(b_) : bf_lo(b_)); }
        const float c0 = gelu_tanh(dv0) * (gw0[n] * su0[n]), c1 = gelu_tanh(dv1) * (gw1[n] * su1[n]);
        const int hi_ = __builtin_amdgcn_cvt_pk_fp8_f32(64.0f * c0, 64.0f * c1, 0, false);
        const int lo_ = __builtin_amdgcn_cvt_pk_fp8_f32(64.0f * c0 - __builtin_amdgcn_cvt_f32_fp8(hi_, 0), 64.0f * c1 - __builtin_amdgcn_cvt_f32_fp8(hi_, 1), 0, false);
        unsigned char* cb = ws + WS_CB + (size_t)t * 256;
        const int rho0 = 8 * (jj[0] & 15) + (jj[0] >> 4), rho1 = 8 * (jj[1] & 15) + (jj[1] >> 4);
        cb[rho0] = (unsigned char)(hi_ & 255); cb[rho1] = (unsigned char)((hi_ >> 8) & 255); cb[128 + rho0] = (unsigned char)(lo_ & 255); cb[128 + rho1] = (unsigned char)((lo_ >> 8) & 255);
    }
}
__device__ __forceinline__ void p8x_wave(const Args& A, LAS unsigned char* lds, int wave, int lane_, int qset) {
    unsigned char* ws = A.ws;
    typedef int v2i_ __attribute__((ext_vector_type(2)));
    const __amdgpu_buffer_rsrc_t rsrc = __builtin_amdgcn_make_buffer_rsrc((void*)ws, 0, 0x7FFFFFFF, 0x00020000);
    int lane = lane_; asm volatile("" : "+v"(lane));
    LAS unsigned char* rowbuf = lds + wave * 16384;
    const int i16 = lane & 15, g = lane >> 4, l3 = lane >> 3, ih = i16 >> 1;
    const int rb = (32 * g + i16) * 128;
    const int pc0 = ((lane & 7) ^ (l3 >> 1)) << 4, pc1 = ((lane & 7) ^ (4 + (l3 >> 1))) << 4;
    const int vo_a = l3 * 64, vo_b = g * 16, vo_o = (i16 * 16 + g * 4) * 2;
    int scm[16];
#pragma unroll
    for (int m = 0; m < 16; ++m) scm[m] = (i16 == m) ? 0x79797979 : 0;
    int offp[8];
#pragma unroll
    for (int p = 0; p < 8; ++p) offp[p] = rb + ((p ^ ih) << 4);
    unsigned* Q = (unsigned*)(ws + WS_CTL + CTL_P7Q) + qset * 512;
    const int xs = (int)(xb_xcc_id() & 7u);
#pragma unroll 1
    for (int k = 0; k < 8; ++k) {
        const int s = (xs + k) & 7;
        const int so_w = (int)WS_WU4 + s * (16384 * 128);
#pragma unroll 1
        for (;;) {
            unsigned blk = 0u; if (lane == 0) blk = xb_add(Q + s * 64, 1u);
            blk = (unsigned)__builtin_amdgcn_readfirstlane((int)blk);
            if (blk >= (unsigned)(M / P7_TB)) break;
            const int t0 = (int)blk * P7_TB;
            u32x4 ea[4]; i32x8 Bh, Bl;
#define P8X_IDX(tt) do { const int so_ = (int)WS_IDX + (tt) * 512; \
            _Pragma("unroll") for (int q_ = 0; q_ < 4; ++q_) ea[q_] = __builtin_bit_cast(u32x4, __builtin_amdgcn_raw_buffer_load_b128(rsrc, vo_a + 16 * q_, so_, 0)); } while (0)
#define P8X_BLD(tt) do { const int so_ = (int)WS_CB + (tt) * 256; \
            const u32x4 b0_ = __builtin_bit_cast(u32x4, __builtin_amdgcn_raw_buffer_load_b128(rsrc, vo_b, so_, 0)), b1_ = __builtin_bit_cast(u32x4, __builtin_amdgcn_raw_buffer_load_b128(rsrc, vo_b + 64, so_, 0)); \
            const u32x4 c0_ = __builtin_bit_cast(u32x4, __builtin_amdgcn_raw_buffer_load_b128(rsrc, vo_b + 128, so_, 0)), c1_ = __builtin_bit_cast(u32x4, __builtin_amdgcn_raw_buffer_load_b128(rsrc, vo_b + 192, so_, 0)); \
            Bh = (i32x8){(int)b0_.x, (int)b0_.y, (int)b0_.z, (int)b0_.w, (int)b1_.x, (int)b1_.y, (int)b1_.z, (int)b1_.w}; \
            Bl = (i32x8){(int)c0_.x, (int)c0_.y, (int)c0_.z, (int)c0_.w, (int)c1_.x, (int)c1_.y, (int)c1_.z, (int)c1_.w}; } while (0)
#define P8X_DMA() do { _Pragma("unroll") for (int i = 0; i < 16; ++i) __builtin_amdgcn_raw_ptr_buffer_load_lds(rsrc, (LAS void*)(rowbuf + i * 1024), 16, (int)(ea[i >> 2][i & 3] * 128u) + ((i & 1) ? pc1 : pc0), so_w, 0, 0); } while (0)
            P8X_IDX(t0);
            P8X_BLD(t0);
            P8X_DMA();
            P8X_IDX(t0 + 1);
            __builtin_amdgcn_raw_buffer_store_b32(0u, rsrc, lane * 4, (int)WS_CTL + 950 * 1024, 0);
#pragma unroll 1
            for (int v = 0; v < P7_TB; ++v) {
                if (v == 0) asm volatile("s_waitcnt vmcnt(0)" ::: "memory"); else asm volatile("s_waitcnt vmcnt(1)" ::: "memory");
                f32x4 acc0 = {0.f, 0.f, 0.f, 0.f}, acc1 = {0.f, 0.f, 0.f, 0.f};
#pragma unroll
                for (int m = 0; m < 16; ++m) {
                    const v2i_ r0 = __builtin_amdgcn_ds_read_tr4_b64_v2i32((LAS v2i_*)(rowbuf + offp[m >> 1] + (m & 1) * 8)), r1 = __builtin_amdgcn_ds_read_tr4_b64_v2i32((LAS v2i_*)(rowbuf + offp[m >> 1] + 2048 + (m & 1) * 8));
                    const i32x8 a_ = (i32x8){r0.x, r0.y, r1.x, r1.y, 0, 0, 0, 0};
                    if (m & 1) { acc1 = __builtin_amdgcn_mfma_scale_f32_16x16x128_f8f6f4(a_, Bh, acc1, 4, 0, 0, 0x7F7F7F7F, 0, scm[m]); acc1 = __builtin_amdgcn_mfma_scale_f32_16x16x128_f8f6f4(a_, Bl, acc1, 4, 0, 0, 0x7F7F7F7F, 0, scm[m]); }
                    else         { acc0 = __builtin_amdgcn_mfma_scale_f32_16x16x128_f8f6f4(a_, Bh, acc0, 4, 0, 0, 0x7F7F7F7F, 0, scm[m]); acc0 = __builtin_amdgcn_mfma_scale_f32_16x16x128_f8f6f4(a_, Bl, acc0, 4, 0, 0, 0x7F7F7F7F, 0, scm[m]); }
                }
                if (v + 1 < P7_TB) { asm volatile("s_waitcnt lgkmcnt(0)" ::: "memory"); P8X_DMA(); P8X_BLD(t0 + v + 1); }
                { const int vn = v + 2 < P7_TB ? v + 2 : P7_TB - 1; P8X_IDX(t0 + vn); }
                u32x2 o_; o_.x = pk2(acc0[0] + acc1[0], acc0[1] + acc1[1]); o_.y = pk2(acc0[2] + acc1[2], acc0[3] + acc1[3]);
                __builtin_amdgcn_raw_buffer_store_b64(o_, rsrc, vo_o, (int)WS_PO + ((t0 + v) * 2048 + 256 * s) * 2, 0);
            }
            asm volatile("s_waitcnt vmcnt(0)" ::: "memory");
#undef P8X_IDX
#undef P8X_BLD
#undef P8X_DMA
        }
    }
}
__device__ __forceinline__ void p7c_token(const Args& A, int t, int lane) {
    float* orow = A.out + (size_t)t * 2048; const bf16_t* prow = (const bf16_t*)(A.ws + WS_PO) + (size_t)t * 2048; const bf16_t* xrow = (const bf16_t*)(A.ws + WS_GA) + (size_t)t * 2048; const float* g = A.in[18];
    f32x4 y[8]; float s2 = 0.f;
#pragma unroll
    for (int j = 0; j < 4; ++j) { const u32x4 p = *(const u32x4*)(prow + 512 * j + 8 * lane), x = *(const u32x4*)(xrow + 512 * j + 8 * lane);
        y[2 * j] = (f32x4){bf_lo(p.x) + bf_lo(x.x), bf_hi(p.x) + bf_hi(x.x), bf_lo(p.y) + bf_lo(x.y), bf_hi(p.y) + bf_hi(x.y)};
        y[2 * j + 1] = (f32x4){bf_lo(p.z) + bf_lo(x.z), bf_hi(p.z) + bf_hi(x.z), bf_lo(p.w) + bf_lo(x.w), bf_hi(p.w) + bf_hi(x.w)};
        s2 += (y[2 * j].x * y[2 * j].x + y[2 * j].y * y[2 * j].y) + (y[2 * j].z * y[2 * j].z + y[2 * j].w * y[2 * j].w) + (y[2 * j + 1].x * y[2 * j + 1].x + y[2 * j + 1].y * y[2 * j + 1].y) + (y[2 * j + 1].z * y[2 * j + 1].z + y[2 * j + 1].w * y[2 * j + 1].w); }
    const float rs2 = __builtin_amdgcn_rsqf(dpp_sum(s2) * (1.0f / 2048.0f) + EPS);
#pragma unroll
    for (int j = 0; j < 4; ++j) { const f32x4 g0 = *(const f32x4*)(g + 512 * j + 8 * lane), g1 = *(const f32x4*)(g + 512 * j + 8 * lane + 4);
        *(f32x4*)(orow + 512 * j + 8 * lane) = y[2 * j] * rs2 * g0; *(f32x4*)(orow + 512 * j + 8 * lane + 4) = y[2 * j + 1] * rs2 * g1; }
}

__global__ void __launch_bounds__(NWAVES * 64, 2) fwd(Args args) {
    extern __shared__ __attribute__((aligned(16))) unsigned char lds_raw[];
    LAS unsigned char* lds = (LAS unsigned char*)lds_raw;
    const int tid = threadIdx.x, lane = tid & 63, wave = __builtin_amdgcn_readfirstlane(tid >> 6);
    const int G = gridDim.x; const int bx = blockIdx.x; const int vcu = (G % 8 == 0) ? (bx % 8) * (G / 8) + bx / 8 : bx;
    unsigned char* ws = args.ws;
    unsigned* ctl = (unsigned*)(ws + WS_CTL);
    for (int u = tid; u < (LDS_BYTES - LDSCTL_OFF) / 4; u += NWAVES * 64) ((LAS unsigned*)(lds + LDSCTL_OFF))[u] = 0u;
    __syncthreads();
    const int lo = args.ph_lo, hi = args.ph_hi;
    const XcdBarrier bar = xcd_barrier_post(ctl + CW_BAR + args.li * XCD_BAR_WORDS, (volatile LAS unsigned*)(lds + LDSCTL_OFF + 64));
#define IN(k) (((PH_MASK >> (k)) & 1) && lo <= (k) && (k) < hi)
#define BOTH(k) (IN(k) && IN((k) + 1))
#define GRID_BAR() xcd_barrier(bar)

    if (IN(0)) { p0_prologue(args, lds, vcu, G, wave, lane, tid); if (BOTH(0)) GRID_BAR(); }

    if (IN(1)) {
        const bool split = G > 64;
        if (!split || bx < 32) { SchedP1 S{G, bx, (unsigned)WS_H1, (unsigned)WS_WIN, (unsigned)WS_MEMN, (unsigned)WS_WKV, 0, 32};
            EpiP1 E{(bf16_t*)(ws + WS_GA), (bf16_t*)(ws + WS_BG), (bf16_t*)(ws + WS_CH), (bf16_t*)(ws + WS_KF), (bf16_t*)(ws + WS_VF)};
            pg8::gemm_phase<EpiP1, SchedP1>(lds, ws, 2048, S, E); }
        if (!split) p0b_convert(args, lds, vcu, G, wave, lane);
        else if (bx >= 32) p0b_convert(args, lds, bx - 32, G - 32, wave, lane);
        if (BOTH(1)) GRID_BAR();
    }

    if (IN(2)) {
        { SchedP1F S{G, bx, (unsigned)WS_H8, (unsigned)WS_W8};
          EpiP1F E{(bf16_t*)(ws + WS_GA), (bf16_t*)(ws + WS_BG), (bf16_t*)(ws + WS_CH), (bf16_t*)(ws + WS_Q), ws + WS_SG8, (const float*)(ws + WS_HS), (const unsigned*)(ws + WS_CTL + CTL_CMX)};
          pg8::gemm_phase<EpiP1F, SchedP1F, 2>(lds, ws, 1024, S, E); }
        if (BOTH(2)) GRID_BAR();
    }

    if (IN(3)) {
        _Pragma("unroll 1") for (int rep = 0; rep < P2_REP_G; ++rep) { asm volatile("" ::: "memory"); for (int blk = vcu; blk < M / 128; blk += G) p2_gmlp_block(args, lds, blk, wave, lane, tid); }
        _Pragma("unroll 1") for (int rep = 0; rep < P2_REP_C; ++rep) { asm volatile("" ::: "memory"); p2_conv(args, vcu, G, tid); }
        _Pragma("unroll 1") for (int rep = 0; rep < P2_REP_A; ++rep) { asm volatile("" ::: "memory"); for (int a = vcu; a < 512; a += G) { const int b = a >> 7, h = (a >> 5) & 3, qt = a & 31; p2_attn_unit(args, lds, b, h, qt * 256 + wave * 32, lane, tid); } __syncthreads(); }
        if (BOTH(3)) GRID_BAR();
    }

    if (IN(4)) {
        SchedP3 S{G, bx};
        EpiP3 E{(bf16_t*)(ws + WS_H1), ws + WS_SG8};
        pg8::gemm_phase<EpiP3, SchedP3>(lds, ws, 1024, S, E);
        if (BOTH(4)) GRID_BAR();
    }

    if (IN(5)) {
        SchedSimple S{G, bx, 128, 8, (unsigned)WS_H1, (unsigned)WS_WOUT};
        EpiP4 E{args.in[0], args.out, (bf16_t*)(ws + WS_GA), (float*)(ws + WS_SSP)};
        pg8::gemm_phase<EpiP4, SchedSimple>(lds, ws, 2048, S, E);
        if (BOTH(5)) GRID_BAR();
    }

    if (IN(6)) {
        SchedSimple S{G, bx, 128, 8, (unsigned)WS_GA, (unsigned)WS_WQ};
        EpiBf E{(bf16_t*)(ws + WS_PQ)};
        pg8::gemm_phase<EpiBf, SchedSimple>(lds, ws, 2048, S, E);
        if (BOTH(6)) GRID_BAR();
    }

    if (IN(7)) {
        for (int it = vcu; it < 256; it += G) {
            const int head = it & 7, chunk = it >> 3;
            __syncthreads();
            {
                const u32x4* src = (const u32x4*)(ws + WS_KEYF) + (size_t)head * 4096;
#pragma unroll
                for (int j = 0; j < 8; ++j) *(LAS u32x4*)(lds + (size_t)(j * 512 + tid) * 16) = src[j * 512 + tid];
            }
            __syncthreads();
#pragma unroll 1
            for (int q = 0; q < 4; ++q) { asm volatile("" ::: "memory"); p6_tile(args, lds, head, chunk * 1024 + (q * 8 + wave) * 32, lane); }
        }
        if (BOTH(7)) GRID_BAR();
    }

    if (IN(8)) {
        _Pragma("unroll 1") for (int rep = 0; rep < P7X_REP; ++rep) { asm volatile("" ::: "memory"); p7x_wave(args, lds, wave, lane, args.li * 4 + rep); GRID_BAR(); }
        _Pragma("unroll 1") for (int rep = 0; rep < P7Y_REP; ++rep) { asm volatile("" ::: "memory");
            if (M % (G * NWAVES * 4) == 0) { _Pragma("unroll 1") for (int t = vcu * NWAVES + wave; t < M; t += G * NWAVES * 4) p7y_tokens<4>(args, t, G * NWAVES, lane); }
            else { _Pragma("unroll 1") for (int t = vcu * NWAVES + wave; t < M; t += G * NWAVES) p7y_tokens<1>(args, t, G * NWAVES, lane); } }
        GRID_BAR();
        _Pragma("unroll 1") for (int rep = 0; rep < P8X_REP; ++rep) { asm volatile("" ::: "memory"); p8x_wave(args, lds, wave, lane, args.li * 4 + 2 + rep); if (rep + 1 < P8X_REP) GRID_BAR(); }
        if (BOTH(8)) GRID_BAR();
    }
    if (IN(9)) {
        for (int t = vcu * NWAVES + wave; t < M; t += G * NWAVES) p7c_token(args, t, lane);
    }
#undef IN
#undef BOTH
#undef GRID_BAR
}

extern "C" void kernel_launch(void* const* d_in, const int* in_sizes, int n_in, void* d_out, int out_size, void* d_ws, size_t ws_size, hipStream_t stream) {
    static int grid = 0;
    if (grid == 0) {
        if (n_in != 19 || out_size != M * D || ws_size < WS_END) { fprintf(stderr, "kernel_launch: unexpected shapes (n_in %d out %d ws %zu)\n", n_in, out_size, ws_size); grid = -1; return; }
        int dev = 0, cus = 0, per_cu = 0;
        if (hipGetDevice(&dev) != hipSuccess || hipDeviceGetAttribute(&cus, hipDeviceAttributeMultiprocessorCount, dev) != hipSuccess) { grid = -1; return; }
        if (hipFuncSetAttribute((const void*)fwd, hipFuncAttributeMaxDynamicSharedMemorySize, LDS_BYTES) != hipSuccess) { fprintf(stderr, "kernel_launch: hipFuncSetAttribute failed\n"); grid = -1; return; }
        if (hipOccupancyMaxActiveBlocksPerMultiprocessor(&per_cu, (const void*)fwd, NWAVES * 64, LDS_BYTES) != hipSuccess || per_cu < 1) { fprintf(stderr, "kernel_launch: occupancy query says %d\n", per_cu); }
        (void)hipGetLastError();
        grid = cus;
    }
    if (grid < 0) return;
    (void)hipMemsetAsync((char*)d_ws + WS_CTL, 0, CTL_ZERO_BYTES, stream);
    Args a{};
    for (int i = 0; i < 19; ++i) a.in[i] = (const float*)d_in[i];
    a.out = (float*)d_out; a.ws = (unsigned char*)d_ws;
#if MK_SPLIT
    static const int seq[] = MK_SEQ;
    for (int i = 0; i < (int)(sizeof(seq) / sizeof(seq[0])); ++i) { a.ph_lo = seq[i]; a.ph_hi = seq[i] + 1; a.li = i; hipLaunchKernelGGL(fwd, dim3(grid), dim3(NWAVES * 64), LDS_BYTES, stream, a); }
#else
    a.ph_lo = 0; a.ph_hi = NPHASE;
    hipLaunchKernelGGL(fwd, dim3(grid), dim3(NWAVES * 64), LDS_BYTES, stream, a);
#endif
}
```

```cpp
#include <hip/hip_runtime.h>
#include <cstdio>
#include <cstdint>

#ifndef MK_SPLIT
#define MK_SPLIT 0
#endif
#ifndef PH_MASK
#define PH_MASK 0x3FF
#endif
#ifndef MK_SEQ
#define MK_SEQ {0, 1, 2, 3, 4, 5, 6, 7, 8, 9}
#endif
#ifndef P2_REP_G
#define P2_REP_G 1
#endif
#ifndef P2_REP_C
#define P2_REP_C 1
#endif
#ifndef P2_REP_A
#define P2_REP_A 1
#endif
#ifndef P8X_REP
#define P8X_REP 1
#endif
#ifndef P7Y_REP
#define P7Y_REP 1
#endif
#ifndef P7X_REP
#define P7X_REP 1
#endif

#define LAS __attribute__((address_space(3)))
#define GAS __attribute__((address_space(1)))
typedef unsigned short bf16_t;
typedef short bf16x8 __attribute__((ext_vector_type(8)));
typedef float f32x2 __attribute__((ext_vector_type(2)));
typedef float f32x4 __attribute__((ext_vector_type(4)));
typedef float f32x16 __attribute__((ext_vector_type(16)));
typedef unsigned u32x2 __attribute__((ext_vector_type(2)));
typedef unsigned u32x4 __attribute__((ext_vector_type(4)));
typedef __bf16 bf16x2_t __attribute__((ext_vector_type(2)));
typedef unsigned u32x16 __attribute__((ext_vector_type(16)));
typedef int i32x4 __attribute__((ext_vector_type(4)));
typedef unsigned u32x6 __attribute__((ext_vector_type(6)));
typedef unsigned u32x3 __attribute__((ext_vector_type(3)));
typedef float f32x32 __attribute__((ext_vector_type(32)));
typedef int i32x8 __attribute__((ext_vector_type(8)));

constexpr int BATCH = 4, SEQ = 8192, D = 2048, M = BATCH * SEQ, NMEM = 256, MM = BATCH * NMEM;
constexpr int DIN = 12288;
constexpr float EPS = 1e-6f;
constexpr int NWAVES = 8;
constexpr int NPHASE = 10;

constexpr size_t MiB = 1u << 20;
constexpr size_t WS_CTL = 0, CTL_ZERO_BYTES = 1 * MiB;
constexpr size_t WS_SSP = 1 * MiB;
constexpr size_t WS_WIN = 5 * MiB;
constexpr size_t WS_WKV = 53 * MiB;
constexpr size_t WS_WB = 61 * MiB;
constexpr size_t WS_WOUT = 73 * MiB;
constexpr size_t WS_WQ = 81 * MiB;
constexpr size_t WS_KEYF = 89 * MiB;
constexpr size_t WS_WSM = 89 * MiB + 512 * 1024;
constexpr size_t WS_MEMN = 90 * MiB;
constexpr size_t WS_KF = 94 * MiB;
constexpr size_t WS_VF = 96 * MiB;
constexpr size_t WS_SCU = 162 * MiB + 65536;
constexpr size_t WS_H1 = 226 * MiB;
constexpr size_t WS_GA = 354 * MiB;
constexpr size_t WS_BG = 482 * MiB;
constexpr size_t WS_CH = 546 * MiB;
constexpr size_t WS_Q = 610 * MiB;
constexpr size_t WS_SG8 = 674 * MiB;
constexpr size_t WS_PQ = 674 * MiB;
constexpr size_t WS_IDX = 802 * MiB;
constexpr size_t WS_GW = 818 * MiB;
constexpr size_t WS_YC = 930 * MiB;
constexpr size_t WS_PO = 226 * MiB;
constexpr size_t WS_YA = 866 * MiB;
constexpr size_t WS_H8 = 930 * MiB;
constexpr size_t WS_END = 994 * MiB;
constexpr size_t WS_W8 = 25 * MiB;
constexpr size_t WS_HS = 162 * MiB + 131072;
constexpr size_t WS_WU4 = 130 * MiB;
constexpr size_t WS_CB = 834 * MiB;
constexpr size_t WS_WD4 = 98 * MiB;
constexpr size_t WS_WDS = 114 * MiB;
constexpr size_t WS_PART = 482 * MiB;
constexpr size_t WS_RS = 162 * MiB + 262144;
constexpr size_t CTL_P7Q = 768 * 1024;
constexpr size_t CTL_CMX = 512 * 1024;
constexpr int CW_TMO = 0, CW_BAR = 4096;

constexpr int RING_BYTES = 131072, LDSCTL_OFF = RING_BYTES, LDS_BYTES = 147456;

__device__ __forceinline__ unsigned pk2(float lo, float hi) { f32x2 v = {lo, hi}; bf16x2_t b = __builtin_convertvector(v, bf16x2_t); return __builtin_bit_cast(unsigned, b); }
__device__ __forceinline__ float bf_lo(unsigned u) { return __uint_as_float(u << 16); }
__device__ __forceinline__ float bf_hi(unsigned u) { return __uint_as_float(u & 0xffff0000u); }
__device__ __forceinline__ float gelu_tanh(float x) {
    const float t = x * (1.0f + 0.044715f * x * x) * (-2.302208198f);
    return x * __builtin_amdgcn_rcpf(1.0f + __builtin_amdgcn_exp2f(t));
}
__device__ __forceinline__ float sigmoidf_(float x) { return __builtin_amdgcn_rcpf(1.0f + __builtin_amdgcn_exp2f(x * -1.44269504f)); }
__device__ __forceinline__ float wave_sum(float v) {
#pragma unroll
    for (int o = 1; o < 64; o <<= 1) v += __shfl_xor(v, o);
    return v;
}
#define MFMA32(a, b, c) __builtin_amdgcn_mfma_f32_32x32x16_bf16((a), (b), (c), 0, 0, 0)

namespace pg8 {
constexpr int BM = 256, BK = 64, HALF = 128, HTB = HALF * BK * 2, STAGE_BYTES = 8 * HTB;
__host__ __device__ __forceinline__ int lds_byte(int r, int c) { const int st = (r >> 4) * 2 + (c >> 5), rr = r & 15, cc = c & 31, ob = rr * 64 + cc * 2; return st * 1024 + (ob ^ (((ob >> 9) & 1) << 5)); }
__host__ __device__ __forceinline__ void stage_rc(int b, int& R, int& C) { const int st = b / 1024, sb = b % 1024, swz = sb ^ (((sb >> 9) & 1) << 5); R = (st >> 1) * 16 + swz / 64; C = (st & 1) * 32 + (swz % 64) / 2; }
__host__ __device__ __forceinline__ int perm32(int rho) { const int n = rho >> 4, i = rho & 15; return 8 * (i >> 2) + 4 * n + (i & 3); }

struct Unit { int pm, pn, kind, aux; unsigned a, b; };

__device__ __forceinline__ void tile_map(int L, int nM, int nN, int& pm, int& pn) {
    const int nwg = nM * nN; int wgid = L;
    { const int q = nwg / 8, r = nwg % 8, xcd = wgid % 8, off = wgid / 8; wgid = (xcd < r ? xcd * (q + 1) : r * (q + 1) + (xcd - r) * q) + off; }
    const int nig = 8 * nN, gid = wgid / nig, fm = gid * 8, gsz = (nM - fm) < 8 ? (nM - fm) : 8;
    pm = fm + ((wgid % nig) % gsz); pn = (wgid % nig) / gsz;
}

template <class Epi, class Sched, int MODE = 0>
__device__ __forceinline__ void gemm_phase(LAS unsigned char* lds, const unsigned char* wsbase, const int K, const Sched& S, const Epi& E) {
    const __amdgpu_buffer_rsrc_t rsrc = __builtin_amdgcn_make_buffer_rsrc((void*)wsbase, 0, 0x7FFFFFFF, 0x00020000);
    int tid = threadIdx.x; asm volatile("" : "+v"(tid));
    const int wid = __builtin_amdgcn_readfirstlane(tid >> 6), lane = tid & 63, wr = wid >> 2, wc = wid & 3, fr = lane & 15, fq = lane >> 4;
    const int nt = K / BK;
    unsigned voffA[2], voffB[2];
#pragma unroll
    for (int i = 0; i < 2; ++i) { int R, C; stage_rc(tid * 16 + i * 8192, R, C); const int Rb = (R & ~31) + perm32(R & 31);
        voffA[i] = (unsigned)(R * K + C) * 2u; voffB[i] = (unsigned)(Rb * K + C) * 2u; }
    const unsigned kstep = (unsigned)(BK * 2);
    const unsigned hstep = (unsigned)HALF * K * 2;
    const unsigned ldsw = (unsigned)wid * 1024u;
    const int aoff = lds_byte(wr * 64 + fr, fq * 8), boff = lds_byte(wc * 32 + fr, fq * 8);
#define PG8_SA(b, h) (((b) * 2 + (h)) * HTB)
#define PG8_SB(b, h) ((4 + (b) * 2 + (h)) * HTB)
#define PG8_STAGE(bufoff, gbase, voff) do { _Pragma("unroll") for (int _i = 0; _i < 2; ++_i) \
        __builtin_amdgcn_raw_ptr_buffer_load_lds(rsrc, (LAS void*)(lds + (bufoff) + ldsw + _i * 8192), 16, (int)(voff)[_i], (int)(gbase), 0, 0); } while (0)
#define PG8_LDA(dst, b, h) do { _Pragma("unroll") for (int m = 0; m < 4; ++m) _Pragma("unroll") for (int k = 0; k < 2; ++k) dst[m][k] = *(const LAS bf16x8*)(lds + PG8_SA(b, h) + aoff + m * 2048 + k * 1024); } while (0)
#define PG8_LDB(dst, b, h) do { _Pragma("unroll") for (int n = 0; n < 2; ++n) _Pragma("unroll") for (int k = 0; k < 2; ++k) dst[n][k] = *(const LAS bf16x8*)(lds + PG8_SB(b, h) + boff + n * 2048 + k * 1024); } while (0)
#define PG8_CAT(x) __builtin_shufflevector(__builtin_bit_cast(i32x4, x[0]), __builtin_bit_cast(i32x4, x[1]), 0, 1, 2, 3, 4, 5, 6, 7)
#define PG8_MMA(ai, bj, At, Bt) do { __builtin_amdgcn_s_setprio(1); _Pragma("unroll") for (int m = 0; m < 4; ++m) _Pragma("unroll") for (int n = 0; n < 2; ++n) { \
        if constexpr (MODE == 1) acc[ai][bj][m][n] = __builtin_amdgcn_mfma_scale_f32_16x16x128_f8f6f4(PG8_CAT(Bt[n]), PG8_CAT(At[m]), acc[ai][bj][m][n], 0, 0, 0, 0, 0, 0); \
        else if constexpr (MODE == 2) { _Pragma("unroll") for (int k = 0; k < 2; ++k) acc[ai][bj][m][n] = __builtin_bit_cast(f32x4, __builtin_amdgcn_mfma_i32_16x16x64_i8(__builtin_bit_cast(i32x4, Bt[n][k]), __builtin_bit_cast(i32x4, At[m][k]), __builtin_bit_cast(i32x4, acc[ai][bj][m][n]), 0, 0, 0)); } \
        else { _Pragma("unroll") for (int k = 0; k < 2; ++k) acc[ai][bj][m][n] = __builtin_amdgcn_mfma_f32_16x16x32_bf16(Bt[n][k], At[m][k], acc[ai][bj][m][n], 0, 0, 0); } } \
        __builtin_amdgcn_s_setprio(0); } while (0)
#define PG8_WAIT_V(n) asm volatile("s_waitcnt vmcnt(" #n ")" ::: "memory")
#define PG8_WAIT_L(n) asm volatile("s_waitcnt lgkmcnt(" #n ")" ::: "memory")
#define PG8_BAR __builtin_amdgcn_s_barrier()
#define PG8_SCHED __builtin_amdgcn_sched_barrier(0)
    Unit cur, nxt; int ui = 0;
    if (!S.next(0, cur)) return;
    f32x4 acc[2][2][4][2];
#pragma unroll
    for (int a = 0; a < 2; ++a)
#pragma unroll
        for (int b = 0; b < 2; ++b)
#pragma unroll
            for (int m = 0; m < 4; ++m)
#pragma unroll
                for (int n = 0; n < 2; ++n) acc[a][b][m][n] = (f32x4){0.f, 0.f, 0.f, 0.f};
    bf16x8 At[4][2], B0[2][2], B1[2][2];
    unsigned cA = cur.a, cB = cur.b;
    PG8_STAGE(PG8_SB(0, 0), cB, voffB); PG8_STAGE(PG8_SB(0, 1), cB + hstep, voffB); PG8_STAGE(PG8_SA(0, 0), cA, voffA); PG8_STAGE(PG8_SA(0, 1), cA + hstep, voffA);
    if (wr == 1) PG8_BAR;
    PG8_WAIT_V(2); PG8_BAR;
    PG8_STAGE(PG8_SB(1, 0), cB + kstep, voffB); PG8_STAGE(PG8_SA(1, 0), cA + kstep, voffA); PG8_STAGE(PG8_SB(1, 1), cB + hstep + kstep, voffB);
    PG8_WAIT_V(6); PG8_BAR;
    for (;;) {
        const bool has_next = S.next(ui + 1, nxt);
        const unsigned nA = has_next ? nxt.a : cA, nB = has_next ? nxt.b : cB;
        for (int t = 0; t < nt; t += 2) {
            const bool last = (t == nt - 2);
            const unsigned a1 = cA + (unsigned)(t + 1) * kstep;
            const unsigned a2 = last ? nA : cA + (unsigned)(t + 2) * kstep, b2 = last ? nB : cB + (unsigned)(t + 2) * kstep;
            const unsigned a3 = a2 + kstep, b3 = b2 + kstep;
            PG8_LDB(B0, 0, 0); PG8_LDB(B1, 0, 1); PG8_SCHED; PG8_LDA(At, 0, 0); PG8_STAGE(PG8_SA(1, 1), a1 + hstep, voffA);
            PG8_WAIT_V(8); PG8_WAIT_L(0); PG8_BAR; PG8_MMA(0, 0, At, B0); PG8_MMA(0, 1, At, B1); PG8_BAR; PG8_SCHED;
            PG8_LDA(At, 0, 1); PG8_STAGE(PG8_SB(0, 0), b2, voffB); PG8_STAGE(PG8_SB(0, 1), b2 + hstep, voffB); PG8_STAGE(PG8_SA(0, 0), a2, voffA);
            PG8_WAIT_V(8); PG8_WAIT_L(0); PG8_BAR; PG8_MMA(1, 0, At, B0); PG8_MMA(1, 1, At, B1); PG8_BAR; PG8_SCHED;
            PG8_LDB(B0, 1, 0); PG8_LDB(B1, 1, 1); PG8_SCHED; PG8_LDA(At, 1, 0); PG8_STAGE(PG8_SA(0, 1), a2 + hstep, voffA);
            PG8_WAIT_V(8); PG8_WAIT_L(0); PG8_BAR; PG8_MMA(0, 0, At, B0); PG8_MMA(0, 1, At, B1); PG8_BAR; PG8_SCHED;
            PG8_LDA(At, 1, 1); PG8_STAGE(PG8_SB(1, 0), b3, voffB); PG8_STAGE(PG8_SB(1, 1), b3 + hstep, voffB); PG8_STAGE(PG8_SA(1, 0), a3, voffA);
            PG8_WAIT_V(8); PG8_WAIT_L(0); PG8_BAR; PG8_MMA(1, 0, At, B0); PG8_MMA(1, 1, At, B1); PG8_BAR; PG8_SCHED;
        }
        if (wr == 0) PG8_BAR;
        E(acc, cur, wr, wc, fr, fq);
        if (!has_next) break;
        if constexpr (!Epi::CHAIN) {
#pragma unroll
        for (int a = 0; a < 2; ++a)
#pragma unroll
            for (int b = 0; b < 2; ++b)
#pragma unroll
                for (int m = 0; m < 4; ++m)
#pragma unroll
                    for (int n = 0; n < 2; ++n) acc[a][b][m][n] = (f32x4){0.f, 0.f, 0.f, 0.f};
        }
        cur = nxt; cA = nA; cB = nB; ++ui;
        if (wr == 1) PG8_BAR;
    }
    PG8_WAIT_V(0);
    PG8_BAR;
#undef PG8_SA
#undef PG8_SB
#undef PG8_STAGE
#undef PG8_LDA
#undef PG8_LDB
#undef PG8_MMA
#undef PG8_CAT
#undef PG8_WAIT_V
#undef PG8_WAIT_L
#undef PG8_BAR
#undef PG8_SCHED
}
}
using pg8::Unit;

#define XB_TMO      128
#define XB_XCNT(j)  (256  + 64 * (j))
#define XB_XSUB(j)  (1280 + 64 * (j))
#define XB_XGEN(j)  (2304 + 64 * (j))
#define XB_TOP      3328
#define XB_TOPGEN   3392
#define XCD_BAR_WORDS 3456
#define XB_SPIN_CAP (1u << 18)
__device__ __forceinline__ unsigned xb_ld(unsigned* p)              { return __hip_atomic_load(p, __ATOMIC_RELAXED, __HIP_MEMORY_SCOPE_AGENT); }
__device__ __forceinline__ unsigned xb_add(unsigned* p, unsigned v) { return __hip_atomic_fetch_add(p, v, __ATOMIC_RELAXED, __HIP_MEMORY_SCOPE_AGENT); }
__device__ __forceinline__ unsigned xb_xcc_id() { return (unsigned)__builtin_amdgcn_s_getreg((3 << 11) | 20) & 0xFu; }
#define XB_SPIN(cond, bar) do { unsigned _sp = 0; while (cond) { __builtin_amdgcn_s_sleep(1); \
    if ((++_sp & 255u) == 0u) { if (xb_ld(&(bar)[XB_TMO])) break; if (_sp > XB_SPIN_CAP) { atomicAdd(&(bar)[XB_TMO], 1u); break; } } } } while (0)
struct XcdBarrier { unsigned* bar; unsigned x; volatile LAS unsigned* st; };
__device__ __forceinline__ XcdBarrier xcd_barrier_post(unsigned* bar, volatile LAS unsigned* st) {
    XcdBarrier b; b.bar = bar; b.x = xb_xcc_id(); b.st = st;
    if (threadIdx.x == 0) (void)xb_add(&bar[XB_XCNT(b.x)], 1u);
    return b;
}
__device__ __forceinline__ void xcd_barrier_complete(unsigned* bar, unsigned x, unsigned& nloc, unsigned& nx) {
    const unsigned G = gridDim.x * gridDim.y * gridDim.z;
    unsigned sum, cnt, mine, sp = 0u;
    for (;;) {
        sum = 0u; cnt = 0u; mine = 0u;
#pragma unroll
        for (unsigned j = 0; j < 16; ++j) { const unsigned c = xb_ld(&bar[XB_XCNT(j)]); sum += c; cnt += (c > 0u) ? 1u : 0u; mine = (j == x) ? c : mine; }
        if (sum == G) break;
        __builtin_amdgcn_s_sleep(1);
        if ((++sp & 255u) == 0u) { if (xb_ld(&bar[XB_TMO])) break; if (sp > XB_SPIN_CAP) { atomicAdd(&bar[XB_TMO], 1u); break; } }
    }
    nloc = mine > 0u ? mine : 1u; nx = cnt > 0u ? cnt : 1u;
}
__device__ __forceinline__ void xcd_barrier(const XcdBarrier& b) {
    asm volatile("s_waitcnt vmcnt(0)" ::: "memory");
    __syncthreads();
    if (threadIdx.x == 0) {
        unsigned* bar = b.bar;
        __builtin_amdgcn_s_waitcnt(0);
        unsigned nloc = b.st[0], nx = b.st[1];
        if (nloc == 0u) { xcd_barrier_complete(bar, b.x, nloc, nx); b.st[0] = nloc; b.st[1] = nx; }
        const unsigned old = xb_add(&bar[XB_XSUB(b.x)], 1u);
        const unsigned gen = old / nloc;
        if (old + 1u == (gen + 1u) * nloc) {
            __builtin_amdgcn_fence(__ATOMIC_RELEASE, "agent");
            asm volatile("s_waitcnt vmcnt(0)" ::: "memory");
            const unsigned og = xb_add(&bar[XB_TOP], 1u);
            const unsigned tg = og / nx;
            if (og + 1u == (tg + 1u) * nx) xb_add(&bar[XB_TOPGEN], 1u);
            else XB_SPIN(xb_ld(&bar[XB_TOPGEN]) == tg, bar);
            __builtin_amdgcn_fence(__ATOMIC_ACQUIRE, "agent");
            xb_add(&bar[XB_XGEN(b.x)], 1u);
            asm volatile("s_waitcnt vmcnt(0)" ::: "memory");
        } else {
            XB_SPIN(xb_ld(&bar[XB_XGEN(b.x)]) == gen, bar);
            __builtin_amdgcn_fence(__ATOMIC_ACQUIRE, "agent");
            asm volatile("s_waitcnt vmcnt(0)" ::: "memory");
        }
    }
    __syncthreads();
}

constexpr unsigned TSTEP2048 = 256u * 2048u * 2u, TSTEP1024 = 256u * 1024u * 2u;
struct SchedP1 {
    int G, c; unsigned H1, WIN, MEMN, WKV; int first, count;
    __device__ __forceinline__ bool next(int i, Unit& u) const {
        const int Lr = i * G + c, L = first + Lr;
        if (Lr >= count) return false;
        const bool kv = L < 32;
        const unsigned isv = (unsigned)(L >> 4) & 1u, j = (unsigned)(L & 15);
        const unsigned ak = MEMN + (j >> 2) * TSTEP2048, bk = WKV + (j & 3) * TSTEP2048, av = WKV + (4u + (j >> 2)) * TSTEP2048, bv = MEMN + (j & 3) * TSTEP2048;
        int pm, pn; pg8::tile_map(kv ? 0 : L - 32, 128, 20, pm, pn);
        const int kt = pn < 8 ? 0 : (pn < 12 ? 1 : 2);
        u.pm = kv ? (int)(j >> 2) : pm; u.pn = kv ? (int)(j & 3) : pn; u.kind = kv ? 5 + (int)isv : kt; u.aux = 0;
        u.a = kv ? ak + isv * (av - ak) : H1 + (unsigned)pm * TSTEP2048;
        u.b = kv ? bk + isv * (bv - bk) : WIN + (unsigned)pn * TSTEP2048;
        return true;
    }
};
struct SchedP1F {
    int G, c; unsigned H8, W8;
    __device__ __forceinline__ bool next(int i, Unit& u) const {
        const int L = i * G + c;
        if (L >= 128 * 48) return false;
        pg8::tile_map(L, 128, 48, u.pm, u.pn);
        u.a = H8 + (unsigned)u.pm * TSTEP1024; u.b = W8 + (unsigned)u.pn * TSTEP1024;
        u.kind = u.pn < 8 ? 0 : (u.pn < 12 ? 1 : (u.pn < 20 ? 2 : (u.pn < 24 ? 3 : 4))); u.aux = 0;
        return true;
    }
};
struct SchedP3 {
    int G, c;
    __device__ __forceinline__ bool next(int i, Unit& u) const {
        const int n = i % 3, L = (i / 3) * G + c;
        if (L >= 128 * 8) return false;
        pg8::tile_map(L, 128, 8, u.pm, u.pn);
        u.aux = n; u.kind = 0;
        const unsigned aoff = (n == 0) ? (unsigned)WS_YA : ((n == 1) ? (unsigned)WS_BG : (unsigned)WS_YC);
        u.a = aoff + (unsigned)u.pm * TSTEP1024;
        u.b = (unsigned)WS_WB + (unsigned)n * (2048u * 1024u * 2u) + (unsigned)u.pn * TSTEP1024;
        return true;
    }
};
struct SchedSimple {
    int G, c, nM, nN; unsigned A, B;
    __device__ __forceinline__ bool next(int i, Unit& u) const {
        const int L = i * G + c;
        if (L >= nM * nN) return false;
        pg8::tile_map(L, nM, nN, u.pm, u.pn);
        u.a = A + (unsigned)u.pm * TSTEP2048; u.b = B + (unsigned)u.pn * TSTEP2048; u.kind = 0; u.aux = 0;
        return true;
    }
};

#define EPI_ROWS _Pragma("unroll") for (int ai = 0; ai < 2; ++ai) _Pragma("unroll") for (int m = 0; m < 4; ++m)
#define EPI_BJ _Pragma("unroll") for (int bj = 0; bj < 2; ++bj)
__device__ __forceinline__ u32x4 pack8(const f32x4 v0, const f32x4 v1) { u32x4 w; w.x = pk2(v0[0], v0[1]); w.y = pk2(v0[2], v0[3]); w.z = pk2(v1[0], v1[1]); w.w = pk2(v1[2], v1[3]); return w; }

struct EpiP1 {
    static constexpr bool CHAIN = false;
    bf16_t *GA, *BG, *CH, *KF, *VF;
    __device__ __forceinline__ void operator()(const f32x4 (&acc)[2][2][4][2], const Unit& u, int wr, int wc, int fr, int fq) const {
        asm volatile("" : "+v"(fr), "+v"(fq));
        const int rt0 = 64 * wr + fr, ct0 = 32 * wc + 8 * fq;
        if (u.kind == 0) {
            EPI_ROWS { const int row = u.pm * 256 + 128 * ai + 16 * m + rt0; bf16_t* rp = GA + (size_t)row * 2048 + u.pn * 256 + ct0;
                EPI_BJ { f32x4 v0 = acc[ai][bj][m][0], v1 = acc[ai][bj][m][1];
#pragma unroll
                    for (int j = 0; j < 4; ++j) { v0[j] = gelu_tanh(v0[j]); v1[j] = gelu_tanh(v1[j]); }
                    *(u32x4*)(rp + bj * 128) = pack8(v0, v1); } }
        } else if (u.kind == 1) {
            EPI_ROWS { const int row = u.pm * 256 + 128 * ai + 16 * m + rt0; bf16_t* rp = BG + (size_t)row * 1024 + (u.pn - 8) * 256 + ct0;
                EPI_BJ { *(u32x4*)(rp + bj * 128) = pack8(acc[ai][bj][m][0], acc[ai][bj][m][1]); } }
        } else if (u.kind == 2) {
            EPI_ROWS { const int row = u.pm * 256 + 128 * ai + 16 * m + rt0; bf16_t* rp = CH + (size_t)row * 1024 + (u.pn - 12) * 128 + ct0;
                *(u32x4*)rp = pack8(acc[ai][0][m][0] * acc[ai][1][m][0], acc[ai][0][m][1] * acc[ai][1][m][1]); }
        } else if (u.kind == 5) {
            EPI_ROWS { const int key = 128 * ai + 16 * m + rt0;
                EPI_BJ { const int d = ct0 + 128 * bj;
                    const size_t o = ((((size_t)(u.pm * 4 + u.pn) * 8 + (key >> 5)) * 16 + (d >> 4)) * 64 + (key & 31) + 32 * ((d >> 3) & 1)) * 8;
                    *(u32x4*)(KF + o) = pack8(acc[ai][bj][m][0], acc[ai][bj][m][1]); } }
        } else {
            EPI_ROWS { const int d = 128 * ai + 16 * m + rt0;
                EPI_BJ { const int c = ct0 + 128 * bj; const int kstep = (c >> 4), jh = (c >> 3) & 1;
                    const size_t o = ((((size_t)(u.pn * 4 + u.pm) * 8 + (d >> 5)) * 16 + kstep) * 64 + (d & 31)) * 8 + 4 * jh;
                    const f32x4 v0 = acc[ai][bj][m][0], v1 = acc[ai][bj][m][1];
                    u32x2 w0, w1; w0.x = pk2(v0[0], v0[1]); w0.y = pk2(v0[2], v0[3]); w1.x = pk2(v1[0], v1[1]); w1.y = pk2(v1[2], v1[3]);
                    *(u32x2*)(VF + o) = w0; *(u32x2*)(VF + o + 32 * 8) = w1; } }
        }
    }
};
__device__ __forceinline__ f32x4 i2f4(const f32x4 a) { const i32x4 i = __builtin_bit_cast(i32x4, a); return (f32x4){(float)i[0], (float)i[1], (float)i[2], (float)i[3]}; }
struct EpiP1F {
    static constexpr bool CHAIN = false;
    bf16_t *GA, *BG, *CH, *Q; unsigned char* SG8; const float* HS; const unsigned* CMX;
    __device__ __forceinline__ void operator()(const f32x4 (&acc)[2][2][4][2], const Unit& u, int wr, int wc, int fr, int fq) const {
        asm volatile("" : "+v"(fr), "+v"(fq));
        const int rt0 = 64 * wr + fr, ct0 = 32 * wc + 8 * fq;
        f32x4 cs[2][2];
#pragma unroll
        for (int bj = 0; bj < 2; ++bj)
#pragma unroll
            for (int n = 0; n < 2; ++n) { const u32x4 cb = *(const u32x4*)(CMX + u.pn * 256 + ct0 + 128 * bj + 4 * n);
#pragma unroll
                for (int j = 0; j < 4; ++j) cs[bj][n][j] = __uint_as_float(cb[j]) * (1.0f / 127.0f); }
        float sa8[2][4];
        EPI_ROWS { sa8[ai][m] = HS[u.pm * 256 + 128 * ai + 16 * m + rt0]; }
        if (u.kind == 0) {
            EPI_ROWS { const int row = u.pm * 256 + 128 * ai + 16 * m + rt0; bf16_t* rp = GA + (size_t)row * 2048 + u.pn * 256 + ct0; const float sa = sa8[ai][m];
                EPI_BJ { f32x4 v0 = i2f4(acc[ai][bj][m][0]) * cs[bj][0] * sa, v1 = i2f4(acc[ai][bj][m][1]) * cs[bj][1] * sa;
#pragma unroll
                    for (int j = 0; j < 4; ++j) { v0[j] = gelu_tanh(v0[j]); v1[j] = gelu_tanh(v1[j]); }
                    *(u32x4*)(rp + bj * 128) = pack8(v0, v1); } }
        } else if (u.kind == 1) {
            EPI_ROWS { const int row = u.pm * 256 + 128 * ai + 16 * m + rt0; bf16_t* rp = BG + (size_t)row * 1024 + (u.pn - 8) * 256 + ct0; const float sa = sa8[ai][m];
                EPI_BJ { *(u32x4*)(rp + bj * 128) = pack8(i2f4(acc[ai][bj][m][0]) * cs[bj][0] * sa, i2f4(acc[ai][bj][m][1]) * cs[bj][1] * sa); } }
        } else if (u.kind == 2) {
            EPI_ROWS { const int row = u.pm * 256 + 128 * ai + 16 * m + rt0; bf16_t* rp = CH + (size_t)row * 1024 + (u.pn - 12) * 128 + ct0; const float sa = sa8[ai][m]; const float s2 = sa * sa;
                *(u32x4*)rp = pack8(i2f4(acc[ai][0][m][0]) * i2f4(acc[ai][1][m][0]) * cs[0][0] * cs[1][0] * s2, i2f4(acc[ai][0][m][1]) * i2f4(acc[ai][1][m][1]) * cs[0][1] * cs[1][1] * s2); }
        } else if (u.kind == 3) {
            EPI_ROWS { const int row = u.pm * 256 + 128 * ai + 16 * m + rt0; bf16_t* rp = Q + (size_t)row * 1024 + (u.pn - 20) * 256 + ct0; const float sa = sa8[ai][m];
                EPI_BJ { *(u32x4*)(rp + bj * 128) = pack8(i2f4(acc[ai][bj][m][0]) * cs[bj][0] * sa, i2f4(acc[ai][bj][m][1]) * cs[bj][1] * sa); } }
        } else {
            const int n = (u.pn - 24) >> 3, pnl = (u.pn - 24) & 7;
            unsigned char* tp = SG8 + ((size_t)(n * 128 + u.pm) * 8 + pnl) * 65536 + (size_t)(((wr * 4 + wc) * 8) * 64 + fr + 16 * fq) * 16;
            EPI_ROWS { const float sa = sa8[ai][m] * -1.44269504f; u32x4 w4;
                EPI_BJ { const f32x4 t0 = i2f4(acc[ai][bj][m][0]) * (cs[bj][0] * sa), t1 = i2f4(acc[ai][bj][m][1]) * (cs[bj][1] * sa); u32x2 w = {0u, 0u};
#pragma unroll
                    for (int j = 0; j < 4; ++j) {
                        w.x = __builtin_amdgcn_cvt_pk_u8_f32(__builtin_amdgcn_rcpf(__builtin_fmaf(__builtin_amdgcn_exp2f(t0[j]), 0.00390625f, 0.00390625f)) - 0.5f, j, w.x);
                        w.y = __builtin_amdgcn_cvt_pk_u8_f32(__builtin_amdgcn_rcpf(__builtin_fmaf(__builtin_amdgcn_exp2f(t1[j]), 0.00390625f, 0.00390625f)) - 0.5f, j, w.y); }
                    w4[2 * bj] = w.x; w4[2 * bj + 1] = w.y; }
                *(u32x4*)(tp + (size_t)(ai * 4 + m) * 1024) = w4; }
        }
    }
};
struct EpiP3 {
    static constexpr bool CHAIN = true;
    bf16_t* MG; const unsigned char* SG8;
    __device__ __forceinline__ bool operator()(f32x4 (&acc)[2][2][4][2], const Unit& u, int wr, int wc, int fr, int fq) const {
        asm volatile("" : "+v"(fr), "+v"(fq));
        const int rt0 = 64 * wr + fr, ct0 = 32 * wc + 8 * fq; const int n = u.aux;
        const __amdgpu_buffer_rsrc_t rs_ = __builtin_amdgcn_make_buffer_rsrc((void*)SG8, 0, 0x7FFFFFFF, 0x00020000);
        const int vo = (((wr * 4 + wc) * 8) * 64 + fr + 16 * fq) * 16;
        const int nn = n < 2 ? n : 2;
        const int so = ((nn * 128 + u.pm) * 8 + u.pn) * 65536;
        const int so2 = n < 2 ? so + 128 * 8 * 65536 : so;
        const float last = n < 2 ? 0.0f : 1.0f;
        u32x2 ga[2][4][2], gb[2][4][2];
        EPI_ROWS { const u32x4 a4 = __builtin_bit_cast(u32x4, __builtin_amdgcn_raw_buffer_load_b128(rs_, vo, so + (ai * 4 + m) * 1024, 0)), b4 = __builtin_bit_cast(u32x4, __builtin_amdgcn_raw_buffer_load_b128(rs_, vo, so2 + (ai * 4 + m) * 1024, 0));
            ga[ai][m][0] = (u32x2){a4.x, a4.y}; ga[ai][m][1] = (u32x2){a4.z, a4.w}; gb[ai][m][0] = (u32x2){b4.x, b4.y}; gb[ai][m][1] = (u32x2){b4.z, b4.w}; }
        EPI_ROWS {
            EPI_BJ {
                float r_[8];
#pragma unroll
                for (int j = 0; j < 4; ++j) {
                    const float a0 = (float)((ga[ai][m][bj].x >> (8 * j)) & 255u) + 0.5f, a1 = (float)((ga[ai][m][bj].y >> (8 * j)) & 255u) + 0.5f;
                    const float b0 = (float)((gb[ai][m][bj].x >> (8 * j)) & 255u) + 0.5f, b1 = (float)((gb[ai][m][bj].y >> (8 * j)) & 255u) + 0.5f;
                    r_[j] = a0 * (last != 0.0f ? (1.0f / 256.0f) : __builtin_amdgcn_rcpf(b0)); r_[4 + j] = a1 * (last != 0.0f ? (1.0f / 256.0f) : __builtin_amdgcn_rcpf(b1)); }
#pragma unroll
                for (int j = 0; j < 4; ++j) { asm volatile("v_mul_f32 %0, %0, %1" : "+v"(acc[ai][bj][m][0][j]) : "v"(r_[j])); asm volatile("v_mul_f32 %0, %0, %1" : "+v"(acc[ai][bj][m][1][j]) : "v"(r_[4 + j])); }
                if (n == 2) { const int row = u.pm * 256 + 128 * ai + 16 * m + rt0, col = u.pn * 256 + ct0 + 128 * bj;
                    *(u32x4*)(MG + (size_t)row * 2048 + col) = pack8(acc[ai][bj][m][0], acc[ai][bj][m][1]);
#pragma unroll
                    for (int j = 0; j < 4; ++j) { asm volatile("v_mul_f32 %0, 0, %0" : "+v"(acc[ai][bj][m][0][j])); asm volatile("v_mul_f32 %0, 0, %0" : "+v"(acc[ai][bj][m][1][j])); } } } }
        return true;
    }
};
struct EpiP4 {
    static constexpr bool CHAIN = false;
    const float* X; float* OUT; bf16_t* X2B; float* SSP;
    __device__ __forceinline__ void operator()(const f32x4 (&acc)[2][2][4][2], const Unit& u, int wr, int wc, int fr, int fq) const {
        asm volatile("" : "+v"(fr), "+v"(fq));
        const int rt0 = 64 * wr + fr, ct0 = 32 * wc + 8 * fq;
#pragma unroll
        for (int ai = 0; ai < 2; ++ai) {
            f32x4 xr[4][2][2];
#pragma unroll
            for (int m = 0; m < 4; ++m) { const int row = u.pm * 256 + 128 * ai + 16 * m + rt0;
                EPI_BJ { const size_t o = (size_t)row * 2048 + u.pn * 256 + ct0 + 128 * bj; xr[m][bj][0] = *(const f32x4*)(X + o); xr[m][bj][1] = *(const f32x4*)(X + o + 4); } }
            __builtin_amdgcn_sched_barrier(0);
#pragma unroll
            for (int m = 0; m < 4; ++m) { const int row = u.pm * 256 + 128 * ai + 16 * m + rt0; float ss = 0.f;
                EPI_BJ { const size_t o = (size_t)row * 2048 + u.pn * 256 + ct0 + 128 * bj;
                    const f32x4 v0 = acc[ai][bj][m][0] + xr[m][bj][0], v1 = acc[ai][bj][m][1] + xr[m][bj][1];
                    *(u32x4*)(X2B + o) = pack8(v0, v1);
                    ss += (v0[0] * v0[0] + v0[1] * v0[1]) + (v0[2] * v0[2] + v0[3] * v0[3]) + (v1[0] * v1[0] + v1[1] * v1[1]) + (v1[2] * v1[2] + v1[3] * v1[3]); }
                ss += __shfl_xor(ss, 16); ss += __shfl_xor(ss, 32);
                if (fq == 0) SSP[(size_t)row * 32 + u.pn * 4 + wc] = ss; }
        }
    }
};
struct EpiBf {
    static constexpr bool CHAIN = false;
    bf16_t* O;
    __device__ __forceinline__ void operator()(const f32x4 (&acc)[2][2][4][2], const Unit& u, int wr, int wc, int fr, int fq) const {
        asm volatile("" : "+v"(fr), "+v"(fq));
        const int rt0 = 64 * wr + fr, ct0 = 32 * wc + 8 * fq;
        EPI_ROWS { const int row = u.pm * 256 + 128 * ai + 16 * m + rt0; bf16_t* rp = O + (size_t)row * 2048 + u.pn * 256 + ct0;
            EPI_BJ { *(u32x4*)(rp + bj * 128) = pack8(acc[ai][bj][m][0], acc[ai][bj][m][1]); } }
    }
};

__device__ __forceinline__ void p0_transpose_item(const float* W, int ldw, int scol0, int k0, bf16_t* WT, int drow0, int K, const float* kscale, LAS float* scr, int lane) {
    {
        const int rr = lane >> 3, cq = (lane & 7) * 4; f32x4 v[8];
#pragma unroll
        for (int i = 0; i < 8; ++i) v[i] = *(const f32x4*)(W + (size_t)(k0 + 8 * i + rr) * ldw + scol0 + cq);
#pragma unroll
        for (int i = 0; i < 8; ++i) { const int kk = 8 * i + rr; const float ks = kscale ? kscale[k0 + kk] : 1.0f;
            scr[kk * 33 + cq] = v[i].x * ks; scr[kk * 33 + cq + 1] = v[i].y * ks; scr[kk * 33 + cq + 2] = v[i].z * ks; scr[kk * 33 + cq + 3] = v[i].w * ks; }
    }
    asm volatile("s_waitcnt lgkmcnt(0)" ::: "memory");
    const int c = lane & 7;
#pragma unroll
    for (int j = 0; j < 4; ++j) { const int n = (lane >> 3) + 8 * j; const LAS float* s = scr + (8 * c) * 33 + n;
        u32x4 o; o.x = pk2(s[0 * 33], s[1 * 33]); o.y = pk2(s[2 * 33], s[3 * 33]); o.z = pk2(s[4 * 33], s[5 * 33]); o.w = pk2(s[6 * 33], s[7 * 33]);
        *(u32x4*)(WT + (size_t)(drow0 + n) * K + k0 + 8 * c) = o; }
    asm volatile("s_waitcnt lgkmcnt(0)" ::: "memory");
}
__device__ __forceinline__ int win_src_col(int j) {
    if (j < 3072 || j >= 5120) return j;
    const int lj = j - 3072, q = lj >> 8, lc = lj & 255, ch = q * 128 + (lc & 127);
    return (lc < 128) ? 3072 + ch : 4096 + ch;
}
__device__ __forceinline__ void row_to_bf16(const float* xrow, bf16_t* orow, const float* g, int lane) {
    const f32x4* xr = (const f32x4*)xrow + lane;
    f32x4 v[8]; float s = 0.f;
#pragma unroll
    for (int j = 0; j < 8; ++j) { v[j] = xr[64 * j]; s += (v[j].x * v[j].x + v[j].y * v[j].y) + (v[j].z * v[j].z + v[j].w * v[j].w); }
    float rs = 1.0f;
    if (g) { rs = __builtin_amdgcn_rsqf(wave_sum(s) * (1.0f / 2048.0f) + EPS); }
    u32x2* o8 = (u32x2*)orow + lane;
#pragma unroll
    for (int j = 0; j < 8; ++j) { f32x4 gg = {1.f, 1.f, 1.f, 1.f}; if (g) gg = ((const f32x4*)g)[64 * j + lane];
        u32x2 w; w.x = pk2(v[j].x * rs * gg.x, v[j].y * rs * gg.y); w.y = pk2(v[j].z * rs * gg.z, v[j].w * rs * gg.w); o8[64 * j] = w; }
}

__device__ __forceinline__ void row_to_fp4u(const float* xrow, unsigned char* wu4, float* scale, int e, int lane) {
    const f32x4* xr = (const f32x4*)xrow + lane;
    f32x4 v[8]; float mx = 0.f;
#pragma unroll
    for (int j = 0; j < 8; ++j) { v[j] = xr[64 * j]; mx = fmaxf(mx, fmaxf(fmaxf(fabsf(v[j].x), fabsf(v[j].y)), fmaxf(fabsf(v[j].z), fabsf(v[j].w)))); }
#pragma unroll
    for (int o = 1; o < 64; o <<= 1) mx = fmaxf(mx, __shfl_xor(mx, o));
    const unsigned scb = pk2(mx * (1.0f / 6.0f), 0.f) & 0xffffu;
    const float scr_ = __uint_as_float(scb << 16);
    const float inv = scr_ > 0.f ? 1.0f / scr_ : 0.f;
    if (lane == 0) *scale = scr_;
#pragma unroll
    for (int j = 0; j < 8; ++j) { unsigned h = 0u;
#pragma unroll
        for (int x = 0; x < 4; ++x) { const float f = v[j][x]; const float a = fabsf(f) * inv;
            const unsigned c = (unsigned)(a > 0.25f) + (unsigned)(a > 0.75f) + (unsigned)(a > 1.25f) + (unsigned)(a > 1.75f) + (unsigned)(a > 2.5f) + (unsigned)(a > 3.5f) + (unsigned)(a > 5.0f);
            h |= (c | ((__float_as_uint(f) >> 28) & 8u)) << (4 * x); }
        *(unsigned short*)(wu4 + ((size_t)j * 16384 + e) * 128 + 2 * lane) = (unsigned short)h; }
}
__device__ __forceinline__ void row_h1(const float* xrow, unsigned char* o8row, float* scale, const float* g, int lane) {
    const f32x4* xr = (const f32x4*)xrow + lane;
    f32x4 v[8]; float s = 0.f;
#pragma unroll
    for (int j = 0; j < 8; ++j) { v[j] = xr[64 * j]; s += (v[j].x * v[j].x + v[j].y * v[j].y) + (v[j].z * v[j].z + v[j].w * v[j].w); }
    const float rs = __builtin_amdgcn_rsqf(wave_sum(s) * (1.0f / 2048.0f) + EPS);
    float mx = 0.f;
#pragma unroll
    for (int j = 0; j < 8; ++j) { const f32x4 gg = ((const f32x4*)g)[64 * j + lane]; v[j] = v[j] * rs * gg; mx = fmaxf(mx, fmaxf(fmaxf(fabsf(v[j].x), fabsf(v[j].y)), fmaxf(fabsf(v[j].z), fabsf(v[j].w)))); }
#pragma unroll
    for (int o = 1; o < 64; o <<= 1) mx = fmaxf(mx, __shfl_xor(mx, o));
    const float inv = mx > 0.f ? 127.0f / mx : 0.f;
    if (lane == 0) *scale = mx * (1.0f / 127.0f);
    unsigned* o4 = (unsigned*)o8row + lane;
#pragma unroll
    for (int j = 0; j < 8; ++j) { const int a = (int)rintf(v[j].x * inv), b = (int)rintf(v[j].y * inv), c = (int)rintf(v[j].z * inv), d = (int)rintf(v[j].w * inv);
        o4[64 * j] = (unsigned)(a & 255) | ((unsigned)(b & 255) << 8) | ((unsigned)(c & 255) << 16) | ((unsigned)(d & 255) << 24); }
}
__device__ __forceinline__ void p0_colmax_item(const float* W, int ldw, int col0, int k0, unsigned* cmx, int lane) {
    const int rr = lane >> 3, cq = (lane & 7) * 4; f32x4 v[8];
#pragma unroll
    for (int i = 0; i < 8; ++i) v[i] = *(const f32x4*)(W + (size_t)(k0 + 8 * i + rr) * ldw + col0 + cq);
    f32x4 mx = {0.f, 0.f, 0.f, 0.f};
#pragma unroll
    for (int i = 0; i < 8; ++i) { mx.x = fmaxf(mx.x, fabsf(v[i].x)); mx.y = fmaxf(mx.y, fabsf(v[i].y)); mx.z = fmaxf(mx.z, fabsf(v[i].z)); mx.w = fmaxf(mx.w, fabsf(v[i].w)); }
#pragma unroll
    for (int o = 8; o < 64; o <<= 1) { mx.x = fmaxf(mx.x, __shfl_xor(mx.x, o)); mx.y = fmaxf(mx.y, __shfl_xor(mx.y, o)); mx.z = fmaxf(mx.z, __shfl_xor(mx.z, o)); mx.w = fmaxf(mx.w, __shfl_xor(mx.w, o)); }
    if (lane < 8) { atomicMax(cmx + cq, __float_as_uint(mx.x)); atomicMax(cmx + cq + 1, __float_as_uint(mx.y)); atomicMax(cmx + cq + 2, __float_as_uint(mx.z)); atomicMax(cmx + cq + 3, __float_as_uint(mx.w)); }
}
__device__ __forceinline__ void p0_transpose8_item(const float* W, int ldw, int scol0, int k0, unsigned char* WT, int drow0, const unsigned* cmx, LAS float* scr, int lane) {
    {   const int rr = lane >> 3, cq = (lane & 7) * 4; f32x4 v[8];
#pragma unroll
        for (int i = 0; i < 8; ++i) v[i] = *(const f32x4*)(W + (size_t)(k0 + 8 * i + rr) * ldw + scol0 + cq);
#pragma unroll
        for (int i = 0; i < 8; ++i) { const int kk = 8 * i + rr; scr[kk * 33 + cq] = v[i].x; scr[kk * 33 + cq + 1] = v[i].y; scr[kk * 33 + cq + 2] = v[i].z; scr[kk * 33 + cq + 3] = v[i].w; }
    }
    asm volatile("s_waitcnt lgkmcnt(0)" ::: "memory");
    const int c = lane & 7;
#pragma unroll
    for (int j = 0; j < 4; ++j) { const int n = (lane >> 3) + 8 * j; const LAS float* sp = scr + (8 * c) * 33 + n;
        const float cm = __uint_as_float(cmx[n]); const float inv = cm > 0.f ? 127.0f / cm : 0.f;
        unsigned p0 = 0u, p1 = 0u;
#pragma unroll
        for (int x = 0; x < 4; ++x) { p0 |= (unsigned)((int)rintf(sp[x * 33] * inv) & 255) << (8 * x); p1 |= (unsigned)((int)rintf(sp[(4 + x) * 33] * inv) & 255) << (8 * x); }
        u32x2 o; o.x = p0; o.y = p1;
        *(u32x2*)(WT + (size_t)(drow0 + n) * 2048 + k0 + 8 * c) = o; }
    asm volatile("s_waitcnt lgkmcnt(0)" ::: "memory");
}

__device__ __forceinline__ void row_to_mx4(const float* xrow, unsigned char* wd4, unsigned char* wds, int e, int lane) {
    float v[32]; float mx = 0.f;
#pragma unroll
    for (int q = 0; q < 8; ++q) { const f32x4 x = *(const f32x4*)(xrow + 32 * lane + 4 * q); v[4 * q] = x.x; v[4 * q + 1] = x.y; v[4 * q + 2] = x.z; v[4 * q + 3] = x.w;
        mx = fmaxf(mx, fmaxf(fmaxf(fabsf(x.x), fabsf(x.y)), fmaxf(fabsf(x.z), fabsf(x.w)))); }
    mx = fmaxf(mx, __shfl_xor(mx, 1)); mx = fmaxf(mx, __shfl_xor(mx, 2)); mx = fmaxf(mx, __shfl_xor(mx, 4));
    const unsigned scb = pk2(mx * (1.0f / 6.0f), 0.f) & 0xffffu;
    const float scr_ = __uint_as_float(scb << 16);
    const float inv = scr_ > 0.f ? 1.0f / scr_ : 0.f;
    unsigned w[4] = {0u, 0u, 0u, 0u};
#pragma unroll
    for (int i = 0; i < 32; ++i) { const float a = fabsf(v[i]) * inv;
        const unsigned c = (unsigned)(a > 0.25f) + (unsigned)(a > 0.75f) + (unsigned)(a > 1.25f) + (unsigned)(a > 1.75f) + (unsigned)(a > 2.5f) + (unsigned)(a > 3.5f) + (unsigned)(a > 5.0f);
        w[i >> 3] |= (c | ((__float_as_uint(v[i]) >> 28) & 8u)) << (4 * (i & 7)); }
    const int sl = lane >> 3, b = lane & 7;
    *(u32x4*)(wd4 + ((size_t)sl * 16384 + e) * 128 + b * 16) = (u32x4){w[0], w[1], w[2], w[3]};
    if (b == 0) *(bf16_t*)(wds + (size_t)e * 16 + 2 * sl) = (bf16_t)scb;
}
struct Args { const float* in[19]; float* out; unsigned char* ws; int ph_lo, ph_hi, li, pad; };

__device__ __forceinline__ void p0_prologue(const Args& A, LAS unsigned char* lds, int vcu, int G, int wave, int lane, int tid) {
    unsigned char* ws = A.ws;
    LAS float* scr = (LAS float*)(lds + wave * 16384);
    const int gw = vcu * NWAVES + wave, NGW = G * NWAVES;
    constexpr int I_WIN = 0, I_KV = 32 * 64, I_WB = 3 * 16 * 64, I_WO = 32 * 64, I_WQ = 32 * 64;
    constexpr int NT = I_WIN + I_KV + I_WB + I_WO + I_WQ;
    for (int it = gw; it < NT; it += NGW) {
        int r = it;
        if (r < I_WIN) { const int kb = r / 160, nb = r % 160; p0_transpose_item(A.in[4], DIN, win_src_col(32 * nb), 64 * kb, (bf16_t*)(ws + WS_WIN), 32 * nb, 2048, nullptr, scr, lane); continue; } r -= I_WIN;
        if (r < I_KV) { const int kb = r / 64, nb = r % 64; p0_transpose_item(A.in[10], 2048, 32 * nb, 64 * kb, (bf16_t*)(ws + WS_WKV), 32 * nb, 2048, nullptr, scr, lane); continue; } r -= I_KV;
        if (r < I_WB) { const int n = r / 1024, rr = r % 1024, kb = rr / 64, nb = rr % 64;
            p0_transpose_item(A.in[11] + (size_t)n * 1024 * 2048, 2048, 32 * nb, 64 * kb, (bf16_t*)(ws + WS_WB) + (size_t)n * 2048 * 1024, 32 * nb, 1024, nullptr, scr, lane); continue; } r -= I_WB;
        if (r < I_WO) { const int kb = r / 64, nb = r % 64; p0_transpose_item(A.in[12], 2048, 32 * nb, 64 * kb, (bf16_t*)(ws + WS_WOUT), 32 * nb, 2048, nullptr, scr, lane); continue; } r -= I_WO;
        { const int kb = r / 64, nb = r % 64; p0_transpose_item(A.in[14], 2048, 32 * nb, 64 * kb, (bf16_t*)(ws + WS_WQ), 32 * nb, 2048, A.in[13], scr, lane); }
    }
    for (int r = gw; r < M + MM + 2 * 16384; r += NGW) {
        if (r < M) row_h1(A.in[0] + (size_t)r * 2048, ws + WS_H8 + (size_t)r * 2048, (float*)(ws + WS_HS) + r, A.in[2], lane);
        else if (r < M + MM) { const int q = r - M; row_to_bf16(A.in[1] + (size_t)q * 2048, (bf16_t*)(ws + WS_MEMN) + (size_t)q * 2048, A.in[3], lane); }
        else if (r < M + MM + 16384) { const int q = r - M - MM; row_to_mx4(A.in[16] + (size_t)q * 2048, ws + WS_WD4, ws + WS_WDS, q, lane);
        }
        else { const int q = r - M - MM - 16384; row_to_fp4u(A.in[17] + (size_t)q * 2048, ws + WS_WU4, (float*)(ws + WS_SCU) + q, q, lane); }
    }
    for (int it = gw; it < 32 * 384; it += NGW) { const int kb = it / 384, nb = it % 384; p0_colmax_item(A.in[4], DIN, win_src_col(32 * nb), 64 * kb, (unsigned*)(ws + WS_CTL + CTL_CMX) + 32 * nb, lane); }
    const int gt = vcu * 512 + tid, NGT = G * 512;
    for (int o = gt; o < 32768; o += NGT) {
        const int ln = o & 63, s = (o >> 6) & 7, kb = (o >> 9) & 3, hp = o >> 11;
        const float* src = A.in[15] + ((size_t)hp * 128 + 32 * kb + (ln & 31)) * 128 + 16 * s + 8 * (ln >> 5);
        const f32x4 a = *(const f32x4*)src, b = *(const f32x4*)(src + 4);
        *(u32x4*)((bf16_t*)(ws + WS_KEYF) + (size_t)o * 8) = pack8(a, b);
    }
    for (int o = gt; o < 16384; o += NGT) {
        const int j0 = (o & 15) * 8, i = (o >> 4) & 127;
        const float* src = A.in[5] + (size_t)o * 8;
        f32x4 a = *(const f32x4*)src, b = *(const f32x4*)(src + 4);
        if ((j0 >> 6) > (i >> 6)) { a = (f32x4){0.f, 0.f, 0.f, 0.f}; b = a; }
        *(u32x4*)((bf16_t*)(ws + WS_WSM) + (size_t)o * 8) = pack8(a, b);
    }
}

__device__ __forceinline__ void p0b_convert(const Args& A, LAS unsigned char* lds, int rank, int nranks, int wave, int lane) {
    unsigned char* ws = A.ws; LAS float* scr = (LAS float*)(lds + wave * 16384);
    const int gw = rank * NWAVES + wave, NGW = nranks * NWAVES;
    for (int it = gw; it < 32 * 384; it += NGW) { const int kb = it / 384, nb = it % 384;
        p0_transpose8_item(A.in[4], DIN, win_src_col(32 * nb), 64 * kb, ws + WS_W8, 32 * nb, (const unsigned*)(ws + WS_CTL + CTL_CMX) + 32 * nb, scr, lane); }
}

__device__ __forceinline__ void p2_gmlp_block(const Args& A, LAS unsigned char* lds, int blk, int wave, int lane, int tid) {
    unsigned char* ws = A.ws;
    const bf16_t* GA = (const bf16_t*)(ws + WS_GA); bf16_t* YA = (bf16_t*)(ws + WS_YA); const bf16_t* WSM = (const bf16_t*)(ws + WS_WSM);
    const float *b_s = A.in[6], *ln_g = A.in[7], *ln_b = A.in[8];
    LAS float* stat = (LAS float*)lds;
    LAS bf16_t* vT = (LAS bf16_t*)(lds + 1024);
    const int r0 = blk * 128, hh = lane >> 5, r = lane & 31;
    for (int r4 = 0; r4 < 16; r4 += 4) {
        u32x4 a[4], b[4];
#pragma unroll
        for (int k = 0; k < 4; ++k) { const bf16_t* vp = GA + (size_t)(r0 + wave * 16 + r4 + k) * 2048 + 1024 + lane * 8; a[k] = *(const u32x4*)vp; b[k] = *(const u32x4*)(vp + 512); }
#pragma unroll
        for (int k = 0; k < 4; ++k) { float s = 0.f, q = 0.f;
#pragma unroll
            for (int j = 0; j < 4; ++j) { const float x0 = bf_lo(a[k][j]), x1 = bf_hi(a[k][j]), y0 = bf_lo(b[k][j]), y1 = bf_hi(b[k][j]); s += (x0 + x1) + (y0 + y1); q += (x0 * x0 + x1 * x1) + (y0 * y0 + y1 * y1); }
            s = wave_sum(s); q = wave_sum(q);
            const float mean = s * (1.0f / 1024.0f), var = q * (1.0f / 1024.0f) - mean * mean;
            if (lane == 0) { stat[2 * (wave * 16 + r4 + k)] = mean; stat[2 * (wave * 16 + r4 + k) + 1] = __builtin_amdgcn_rsqf(var + EPS); } }
    }
    __syncthreads();
    constexpr int VTB = 128 * 136;
#pragma unroll 1
    for (int g0 = 0; g0 < 8; g0 += 3) {
        const int ng = (8 - g0) < 3 ? (8 - g0) : 3;
        {
            const int j = tid >> 2, cc = (tid & 3) * 32; const float mu = stat[2 * j], rstd = stat[2 * j + 1];
            u32x4 av[3][4];
#pragma unroll
            for (int gl = 0; gl < 3; ++gl) if (gl < ng) { const bf16_t* vp = GA + (size_t)(r0 + j) * 2048 + 1024 + (g0 + gl) * 128 + cc;
#pragma unroll
                for (int k4 = 0; k4 < 4; ++k4) av[gl][k4] = *(const u32x4*)(vp + 8 * k4); }
#pragma unroll
            for (int gl = 0; gl < 3; ++gl) if (gl < ng) { LAS bf16_t* vt = vT + gl * VTB;
#pragma unroll
                for (int k4 = 0; k4 < 4; ++k4) { const u32x4 a = av[gl][k4]; const int ch = (g0 + gl) * 128 + cc + 8 * k4;
                    const f32x4 gg0 = *(const f32x4*)(ln_g + ch), gg1 = *(const f32x4*)(ln_g + ch + 4), bb0 = *(const f32x4*)(ln_b + ch), bb1 = *(const f32x4*)(ln_b + ch + 4);
#pragma unroll
                    for (int x = 0; x < 4; ++x) { const float lo = (bf_lo(a[x]) - mu) * rstd * (x < 2 ? gg0[2 * x] : gg1[2 * x - 4]) + (x < 2 ? bb0[2 * x] : bb1[2 * x - 4]);
                        const float hi = (bf_hi(a[x]) - mu) * rstd * (x < 2 ? gg0[2 * x + 1] : gg1[2 * x - 3]) + (x < 2 ? bb0[2 * x + 1] : bb1[2 * x - 3]);
                        const unsigned p = pk2(lo, hi);
                        vt[(cc + 8 * k4 + 2 * x) * 136 + j] = (bf16_t)(p & 0xffffu); vt[(cc + 8 * k4 + 2 * x + 1) * 136 + j] = (bf16_t)(p >> 16); } } }
        }
        __syncthreads();
#pragma unroll 1
        for (int gl = 0; gl < ng; ++gl) {
            const int grp = g0 + gl; const LAS bf16_t* vt = vT + gl * VTB;
            const int cb = wave >> 1, ib0 = 2 * (wave & 1);
            f32x16 acc[2];
#pragma unroll
            for (int q = 0; q < 2; ++q)
#pragma unroll
                for (int e = 0; e < 16; ++e) acc[q][e] = 0.f;
            u32x2 uu8[2][4]; float bias2[2];
#pragma unroll
            for (int q = 0; q < 2; ++q) { const int i = (ib0 + q) * 32 + r, row = r0 + i; bias2[q] = b_s[grp * 128 + i];
#pragma unroll
                for (int g4 = 0; g4 < 4; ++g4) uu8[q][g4] = *(const u32x2*)(GA + (size_t)row * 2048 + grp * 128 + cb * 32 + 8 * g4 + 4 * hh); }
#pragma unroll
            for (int s = 0; s < 8; ++s) {
                const bf16x8 a = *(const LAS bf16x8*)(vt + (cb * 32 + r) * 136 + 16 * s + 8 * hh);
#pragma unroll
                for (int q = 0; q < 2; ++q) { const bf16x8 b = *(const bf16x8*)(WSM + ((size_t)grp * 128 + (ib0 + q) * 32 + r) * 128 + 16 * s + 8 * hh); acc[q] = MFMA32(a, b, acc[q]); }
            }
#pragma unroll
            for (int q = 0; q < 2; ++q) { const int i = (ib0 + q) * 32 + r, row = r0 + i; const float bias = bias2[q];
#pragma unroll
                for (int g4 = 0; g4 < 4; ++g4) { const int col = grp * 128 + cb * 32 + 8 * g4 + 4 * hh;
                    const u32x2 uu = uu8[q][g4];
                    u32x2 w; w.x = pk2((acc[q][4 * g4] + bias) * bf_lo(uu.x), (acc[q][4 * g4 + 1] + bias) * bf_hi(uu.x));
                    w.y = pk2((acc[q][4 * g4 + 2] + bias) * bf_lo(uu.y), (acc[q][4 * g4 + 3] + bias) * bf_hi(uu.y));
                    *(u32x2*)(YA + (size_t)row * 1024 + col) = w; } }
        }
        __syncthreads();
    }
}
__device__ __forceinline__ void p2_conv(const Args& A, int vcu, int G, int tid) {
    unsigned char* ws = A.ws; bf16_t* BG = (bf16_t*)(ws + WS_BG); const bf16_t* CH = (const bf16_t*)(ws + WS_CH); const float* cw = A.in[9];
    const int stride = G * 512;
    const int c = ((vcu * 512 + tid) & 127) * 8;
    const f32x4 w0a = *(const f32x4*)(cw + c), w0b = *(const f32x4*)(cw + c + 4), w1a = *(const f32x4*)(cw + 1024 + c), w1b = *(const f32x4*)(cw + 1024 + c + 4), w2a = *(const f32x4*)(cw + 2048 + c), w2b = *(const f32x4*)(cw + 2048 + c + 4);
    for (int idx0 = vcu * 512 + tid; idx0 < M * 128; idx0 += 4 * stride) {
        u32x4 c0[4], c1[4], c2[4], bg[4];
#pragma unroll
        for (int k = 0; k < 4; ++k) { const int idx = idx0 + k * stride; const bool ok = idx < M * 128; const int t = ok ? idx >> 7 : 0, s = t & (SEQ - 1);
            const size_t o = (size_t)t * 1024 + c; const u32x4 z = {0u, 0u, 0u, 0u};
            c0[k] = *(const u32x4*)(CH + o); c1[k] = s >= 1 ? *(const u32x4*)(CH + o - 1024) : z; c2[k] = s >= 2 ? *(const u32x4*)(CH + o - 2048) : z; bg[k] = *(const u32x4*)(BG + o); }
#pragma unroll
        for (int k = 0; k < 4; ++k) { const int idx = idx0 + k * stride; if (idx < M * 128) { const int t = idx >> 7;
            u32x4 y;
#pragma unroll
            for (int x = 0; x < 4; ++x) { const float wl0 = x < 2 ? w0a[2 * x] : w0b[2 * x - 4], wh0 = x < 2 ? w0a[2 * x + 1] : w0b[2 * x - 3], wl1 = x < 2 ? w1a[2 * x] : w1b[2 * x - 4], wh1 = x < 2 ? w1a[2 * x + 1] : w1b[2 * x - 3], wl2 = x < 2 ? w2a[2 * x] : w2b[2 * x - 4], wh2 = x < 2 ? w2a[2 * x + 1] : w2b[2 * x - 3];
                const float lo = bf_lo(bg[k][x]) * (wl0 * bf_lo(c2[k][x]) + wl1 * bf_lo(c1[k][x]) + wl2 * bf_lo(c0[k][x]));
                const float hi = bf_hi(bg[k][x]) * (wh0 * bf_hi(c2[k][x]) + wh1 * bf_hi(c1[k][x]) + wh2 * bf_hi(c0[k][x]));
                y[x] = pk2(lo, hi); }
            *(u32x4*)(BG + (size_t)t * 1024 + c) = y; } }
    }
}
__device__ __forceinline__ void p2_attn_copy(LAS unsigned char* lds, const unsigned char* src, int tid) {
    const u32x4* s4 = (const u32x4*)src + tid;
#pragma unroll
    for (int hlf = 0; hlf < 2; ++hlf) {
        u32x4 v[8];
#pragma unroll
        for (int i = 0; i < 8; ++i) v[i] = s4[(hlf * 8 + i) * 512];
#pragma unroll
        for (int i = 0; i < 8; ++i) *(LAS u32x4*)(lds + (size_t)((hlf * 8 + i) * 512 + tid) * 16) = v[i];
        asm volatile("" ::: "memory");
    }
}
__device__ __forceinline__ void p2_attn_unit(const Args& A, LAS unsigned char* lds, int b, int h, int q0, int lane, int tid) {
    asm volatile("" : "+v"(lane), "+v"(tid));
    unsigned char* ws = A.ws; const bf16_t* Q = (const bf16_t*)(ws + WS_Q); bf16_t* YC = (bf16_t*)(ws + WS_YC);
    const unsigned char* KFg = ws + WS_KF + (size_t)(b * 4 + h) * 131072; const unsigned char* VFg = ws + WS_VF + (size_t)(b * 4 + h) * 131072;
    const LAS bf16x8* FL = (const LAS bf16x8*)lds + lane; const LAS bf16x8* FH = FL + 4096;
    const int r = lane & 31, hh = lane >> 5;
    const size_t trow = (size_t)(b * SEQ + q0 + r) * 1024 + h * 256;
    __syncthreads();
    p2_attn_copy(lds, KFg, tid);
    __syncthreads();
    f32x16 acc[8];
#pragma unroll
    for (int kb = 0; kb < 8; ++kb)
#pragma unroll
        for (int e = 0; e < 16; ++e) acc[kb][e] = 0.f;
#pragma unroll 2
    for (int s = 0; s < 16; ++s) {
        const bf16x8 qf = *(const bf16x8*)(Q + trow + 16 * s + 8 * hh);
#pragma unroll
        for (int kb = 0; kb < 8; ++kb) acc[kb] = MFMA32((kb < 4 ? FL : FH)[((kb & 3) * 16 + s) * 64], qf, acc[kb]);
    }
    constexpr float C1 = 0.0625f * 1.44269504f;
    float mx = -3.0e38f;
#pragma unroll
    for (int kb = 0; kb < 8; ++kb)
#pragma unroll
        for (int e = 0; e < 16; ++e) mx = fmaxf(mx, acc[kb][e]);
    mx = fmaxf(mx, __shfl_xor(mx, 32));
    const float mc = mx * C1; float l = 0.f;
#pragma unroll
    for (int kb = 0; kb < 8; ++kb)
#pragma unroll
        for (int e = 0; e < 16; ++e) { const float p = __builtin_amdgcn_exp2f(acc[kb][e] * C1 - mc); acc[kb][e] = p; l += p; }
    l += __shfl_xor(l, 32);
    bf16x8 pf[16];
#pragma unroll
    for (int kb = 0; kb < 8; ++kb)
#pragma unroll
        for (int s = 0; s < 2; ++s) { u32x4 w; w.x = pk2(acc[kb][8 * s], acc[kb][8 * s + 1]); w.y = pk2(acc[kb][8 * s + 2], acc[kb][8 * s + 3]); w.z = pk2(acc[kb][8 * s + 4], acc[kb][8 * s + 5]); w.w = pk2(acc[kb][8 * s + 6], acc[kb][8 * s + 7]);
            pf[kb * 2 + s] = __builtin_bit_cast(bf16x8, w); }
    const float inv = 1.0f / l;
    __syncthreads();
    p2_attn_copy(lds, VFg, tid);
    __syncthreads();
    int l2 = lane; asm volatile("" : "+v"(l2));
    const size_t orow = (size_t)(b * SEQ + q0 + (l2 & 31)) * 1024 + h * 256 + 4 * (l2 >> 5);
#pragma unroll 1
    for (int db = 0; db < 8; ++db) {
        f32x16 od;
#pragma unroll
        for (int e = 0; e < 16; ++e) od[e] = 0.f;
#pragma unroll
        for (int ks = 0; ks < 16; ++ks) od = MFMA32(FL[(db * 16 + ks) * 64], pf[ks], od);
#pragma unroll
        for (int g4 = 0; g4 < 4; ++g4) { u32x2 w; w.x = pk2(od[4 * g4] * inv, od[4 * g4 + 1] * inv); w.y = pk2(od[4 * g4 + 2] * inv, od[4 * g4 + 3] * inv);
            *(u32x2*)(YC + orow + 32 * db + 8 * g4) = w; }
    }
}

__device__ __forceinline__ unsigned ord_u(float f) { const unsigned b = __float_as_uint(f); return b ^ ((unsigned)((int)b >> 31) | 0x80000000u); }
__device__ __forceinline__ float unord_f(unsigned u) { return __uint_as_float(u ^ ((u & 0x80000000u) ? 0x80000000u : 0xFFFFFFFFu)); }
#define TOPK_INS(L, xx) do { unsigned _x = (xx); _Pragma("unroll") for (int _j = 0; _j < 16; ++_j) { const unsigned _hi = L[_j] > _x ? L[_j] : _x; _x = L[_j] > _x ? _x : L[_j]; L[_j] = _hi; } } while (0)
__device__ __forceinline__ void bitonic_sort16_desc(u32x16& v) {
#pragma unroll
    for (int k = 2; k <= 16; k <<= 1)
#pragma unroll
        for (int j = k >> 1; j > 0; j >>= 1)
#pragma unroll
            for (int i = 0; i < 16; ++i) { const int l = i ^ j; if (l > i) { const unsigned a = v[i], b = v[l], hi = a > b ? a : b, lo = a > b ? b : a; const bool desc = ((i & k) == 0); v[i] = desc ? hi : lo; v[l] = desc ? lo : hi; } }
}
__device__ __forceinline__ void bitonic_merge16_desc(u32x16& v) {
#pragma unroll
    for (int j = 8; j > 0; j >>= 1)
#pragma unroll
        for (int i = 0; i < 16; ++i) { const int l = i ^ j; if (l > i) { const unsigned a = v[i], b = v[l]; v[i] = a > b ? a : b; v[l] = a > b ? b : a; } }
}
__device__ __forceinline__ void top16_merge(u32x16& A, const u32x16 B) {
#pragma unroll
    for (int i = 0; i < 16; ++i) { const unsigned a = A[i], b = B[15 - i]; A[i] = a > b ? a : b; }
    bitonic_merge16_desc(A);
}
__device__ __forceinline__ unsigned sel16(const u32x16 T, unsigned i) {
    unsigned a[8], b[4], c[2];
    const unsigned m0 = 0u - (i & 1u), m1 = 0u - ((i >> 1) & 1u), m2 = 0u - ((i >> 2) & 1u), m3 = 0u - ((i >> 3) & 1u);
#pragma unroll
    for (int q = 0; q < 8; ++q) a[q] = (T[2 * q + 1] & m0) | (T[2 * q] & ~m0);
#pragma unroll
    for (int q = 0; q < 4; ++q) b[q] = (a[2 * q + 1] & m1) | (a[2 * q] & ~m1);
#pragma unroll
    for (int q = 0; q < 2; ++q) c[q] = (b[2 * q + 1] & m2) | (b[2 * q] & ~m2);
    return (c[1] & m3) | (c[0] & ~m3);
}
__device__ __forceinline__ void p6_half(const LAS unsigned char* kl, const bf16_t* pq, int lane, u32x16& L) {
    const int hh = lane >> 5;
    bf16x8 qf[8];
#pragma unroll
    for (int s = 0; s < 8; ++s) qf[s] = *(const bf16x8*)(pq + 16 * s + 8 * hh);
    f32x16 acc[4];
#pragma unroll
    for (int kb = 0; kb < 4; ++kb) {
#pragma unroll
        for (int e = 0; e < 16; ++e) acc[kb][e] = 0.f;
#pragma unroll
        for (int s = 0; s < 8; ++s) acc[kb] = MFMA32(*(const LAS bf16x8*)(kl + ((kb * 8 + s) * 64 + lane) * 16), qf[s], acc[kb]);
    }
    const unsigned nh4 = hh ? 0u : 4u;
    u32x16 X[4];
#pragma unroll
    for (int kb = 0; kb < 4; ++kb) {
#pragma unroll
        for (int e = 0; e < 16; ++e) {
            const unsigned kc = (unsigned)(32 * kb + (e & 3) + 8 * (e >> 2));
            X[kb][e] = (ord_u(acc[kb][e]) & ~127u) | ((~kc) & 0x7Bu) | nh4;
        }
        bitonic_sort16_desc(X[kb]);
    }
    top16_merge(X[0], X[1]); top16_merge(X[2], X[3]); top16_merge(X[0], X[2]);
    L = X[0];
    u32x16 P;
#pragma unroll
    for (int j = 0; j < 16; ++j) P[j] = (unsigned)__shfl_xor((int)L[j], 32);
    top16_merge(L, P);
}
__device__ __forceinline__ void p6_tile(const Args& A, const LAS unsigned char* keys_lds, int head, int t0, int lane) {
    unsigned char* ws = A.ws;
    const int r = lane & 31, hh = lane >> 5, t = t0 + r;
    const bf16_t* pq = (const bf16_t*)(ws + WS_PQ) + (size_t)t * 2048 + head * 256;
    u32x16 L1, L2;
    p6_half(keys_lds, pq, lane, L1);
    p6_half(keys_lds + 32768, pq + 128, lane, L2);
    f32x16 sa, sb;
#pragma unroll
    for (int j = 0; j < 16; ++j) { sa[j] = unord_f(L1[j] & ~127u); sb[j] = unord_f(L2[j] & ~127u); }
    u32x16 CG[4];
#pragma unroll
    for (int q = 0; q < 4; ++q)
#pragma unroll
        for (int j = 0; j < 16; ++j) CG[q][j] = 0u;
    {
        int cnt = 0;
#pragma unroll
        for (int i = 0; i < 16; ++i)
#pragma unroll
            for (int j = 0; j < 16; ++j) if ((i + 1) * (j + 1) <= 16) { CG[cnt >> 4][cnt & 15] = (ord_u(sa[i] + sb[j]) & ~255u) | (unsigned)(255 - (i * 16 + j)); ++cnt; }
    }
#pragma unroll
    for (int q = 0; q < 4; ++q) bitonic_sort16_desc(CG[q]);
    top16_merge(CG[0], CG[1]); top16_merge(CG[2], CG[3]); top16_merge(CG[0], CG[2]);
    const u32x16 C = CG[0];
    const f32x4* sp = (const f32x4*)((const float*)(ws + WS_SSP) + (size_t)t * 32);
    float ss = 0.f;
#pragma unroll
    for (int j = 0; j < 8; ++j) { const f32x4 v = sp[j]; ss += (v.x + v.y) + (v.z + v.w); }
    const float rs = __builtin_amdgcn_rsqf(ss * (1.0f / 2048.0f) + EPS) * 1.44269504f;
    if (head == 0 && hh == 0) ((float*)(ws + WS_RS))[t] = rs * (1.0f / 1.44269504f);
    f32x16 ev; u32x16 ei; float den = 0.f; const float s0 = unord_f(C[0] & ~255u);
#pragma unroll
    for (int k = 0; k < 16; ++k) {
        const unsigned code = 255u - (C[k] & 255u);
        const float sv = unord_f(C[k] & ~255u);
        ev[k] = __builtin_amdgcn_exp2f((sv - s0) * rs); den += ev[k];
        const unsigned i1 = 127u - (sel16(L1, code >> 4) & 127u), i2 = 127u - (sel16(L2, code & 15u) & 127u);
        ei[k] = i1 * 128u + i2;
    }
    const float inv = 1.0f / den;
    u32x4 oi[2]; f32x4 og[2];
#pragma unroll
    for (int j = 0; j < 8; ++j) { oi[j >> 2][j & 3] = hh ? ei[8 + j] : ei[j]; og[j >> 2][j & 3] = (hh ? ev[8 + j] : ev[j]) * inv; }
    const size_t o = (size_t)t * 128 + head * 16 + 8 * hh;
    u32x4* ip = (u32x4*)((unsigned*)(ws + WS_IDX) + o); ip[0] = oi[0]; ip[1] = oi[1];
    f32x4* gp = (f32x4*)((float*)(ws + WS_GW) + o); gp[0] = og[0]; gp[1] = og[1];
}

__device__ __forceinline__ float dpp_sum(float v) {
    int x = (int)__float_as_uint(v);
    v += __uint_as_float((unsigned)__builtin_amdgcn_update_dpp(0, x, 0xB1, 0xF, 0xF, false)); x = (int)__float_as_uint(v);
    v += __uint_as_float((unsigned)__builtin_amdgcn_update_dpp(0, x, 0x4E, 0xF, 0xF, false)); x = (int)__float_as_uint(v);
    v += __uint_as_float((unsigned)__builtin_amdgcn_update_dpp(0, x, 0x141, 0xF, 0xF, false)); x = (int)__float_as_uint(v);
    v += __uint_as_float((unsigned)__builtin_amdgcn_update_dpp(0, x, 0x140, 0xF, 0xF, false)); x = (int)__float_as_uint(v);
    v += __uint_as_float((unsigned)__builtin_amdgcn_update_dpp(0, x, 0x142, 0xA, 0xF, false)); x = (int)__float_as_uint(v);
    v += __uint_as_float((unsigned)__builtin_amdgcn_update_dpp(0, x, 0x143, 0xC, 0xF, false));
    return __uint_as_float((unsigned)__builtin_amdgcn_readlane((int)__float_as_uint(v), 63));
}
constexpr int P7_TB = 64;
__device__ __forceinline__ i32x8 p7x_a8(const u32x4 a) { return (i32x8){(int)a.x, (int)a.y, (int)a.z, (int)a.w, 0, 0, 0, 0}; }
__device__ __forceinline__ void p7x_wave(const Args& A, LAS unsigned char* lds, int wave, int lane_, int qset) {
    unsigned char* ws = A.ws;
    const __amdgpu_buffer_rsrc_t rsrc = __builtin_amdgcn_make_buffer_rsrc((void*)ws, 0, 0x7FFFFFFF, 0x00020000);
    int lane = lane_; asm volatile("" : "+v"(lane));
    LAS unsigned char* rowbuf = lds + wave * 16384;
    LAS unsigned char* hx = lds + LDSCTL_OFF + 4096 + wave * 512;
    const int r = lane & 15, g = lane >> 4, l3 = lane >> 3;
    const int fr = ((r >> 1) & 3) | ((r >> 3) << 2);
    const int rd0 = r * 128 + ((g ^ fr) << 4), rd1 = r * 128 + (((4 + g) ^ fr) << 4);
    const int f0 = (l3 >> 1) & 3;
    const int pc0 = ((lane & 7) ^ f0) << 4, pc1 = ((lane & 7) ^ (f0 | 4)) << 4;
    const int vo_a = l3 * 64, vo_x = lane * 8, vo_p = (16 * (r & 7) + 4 * g) * 2;
    int scg[8];
#pragma unroll
    for (int G_ = 0; G_ < 8; ++G_) scg[G_] = ((r & 7) == G_) ? 0x7F7F7F7F : 0;
    const int hb = (g << 4);
    unsigned* Q = (unsigned*)(ws + WS_CTL + CTL_P7Q) + qset * 512;
    const int xs = (int)(xb_xcc_id() & 7u);
#pragma unroll 1
    for (int k = 0; k < 8; ++k) {
        const int s = (xs + k) & 7;
        const f32x4 gs = *(const f32x4*)(A.in[13] + 256 * s + 4 * lane);
        const int so_w = (int)WS_WD4 + s * (16384 * 128);
#pragma unroll 1
        for (;;) {
            unsigned blk = 0u; if (lane == 0) blk = xb_add(Q + s * 64, 1u);
            blk = (unsigned)__builtin_amdgcn_readfirstlane((int)blk);
            if (blk >= (unsigned)(M / P7_TB)) break;
            const int t0 = (int)blk * P7_TB;
            u32x4 ea[4]; u32x2 xv; float rsv; i32x8 B0, B1, B2, B3;
#define P7X_IDX(tt) do { const int t_ = (tt); const int so_ = (int)WS_IDX + t_ * 512; \
            xv = __builtin_bit_cast(u32x2, __builtin_amdgcn_raw_buffer_load_b64(rsrc, vo_x, (int)WS_GA + t_ * 4096 + s * 512, 0)); \
            rsv = __uint_as_float((unsigned)__builtin_amdgcn_raw_buffer_load_b32(rsrc, 0, (int)WS_RS + t_ * 4, 0)); __builtin_amdgcn_sched_barrier(0); \
            _Pragma("unroll") for (int q_ = 0; q_ < 4; ++q_) ea[q_] = __builtin_bit_cast(u32x4, __builtin_amdgcn_raw_buffer_load_b128(rsrc, vo_a + 16 * q_, so_, 0)); } while (0)
#define P7X_HX() do { const float h0_ = bf_lo(xv.x) * rsv * gs.x, h1_ = bf_hi(xv.x) * rsv * gs.y, h2_ = bf_lo(xv.y) * rsv * gs.z, h3_ = bf_hi(xv.y) * rsv * gs.w; \
            int hi_ = __builtin_amdgcn_cvt_pk_fp8_f32(h0_, h1_, 0, false); hi_ = __builtin_amdgcn_cvt_pk_fp8_f32(h2_, h3_, hi_, true); \
            int lo_ = __builtin_amdgcn_cvt_pk_fp8_f32(h0_ - __builtin_amdgcn_cvt_f32_fp8(hi_, 0), h1_ - __builtin_amdgcn_cvt_f32_fp8(hi_, 1), 0, false); \
            lo_ = __builtin_amdgcn_cvt_pk_fp8_f32(h2_ - __builtin_amdgcn_cvt_f32_fp8(hi_, 2), h3_ - __builtin_amdgcn_cvt_f32_fp8(hi_, 3), lo_, true); \
            *(LAS int*)(hx + 4 * lane) = hi_; *(LAS int*)(hx + 256 + 4 * lane) = lo_; } while (0)
#define P7X_BLD() do { const u32x4 b0_ = *(const LAS u32x4*)(hx + hb), b1_ = *(const LAS u32x4*)(hx + hb + 64), b2_ = *(const LAS u32x4*)(hx + hb + 128), b3_ = *(const LAS u32x4*)(hx + hb + 192); \
            B0 = (i32x8){(int)b0_.x, (int)b0_.y, (int)b0_.z, (int)b0_.w, (int)b1_.x, (int)b1_.y, (int)b1_.z, (int)b1_.w}; \
            B1 = (i32x8){(int)b2_.x, (int)b2_.y, (int)b2_.z, (int)b2_.w, (int)b3_.x, (int)b3_.y, (int)b3_.z, (int)b3_.w}; \
            const u32x4 c0_ = *(const LAS u32x4*)(hx + hb + 256), c1_ = *(const LAS u32x4*)(hx + hb + 320), c2_ = *(const LAS u32x4*)(hx + hb + 384), c3_ = *(const LAS u32x4*)(hx + hb + 448); \
            B2 = (i32x8){(int)c0_.x, (int)c0_.y, (int)c0_.z, (int)c0_.w, (int)c1_.x, (int)c1_.y, (int)c1_.z, (int)c1_.w}; \
            B3 = (i32x8){(int)c2_.x, (int)c2_.y, (int)c2_.z, (int)c2_.w, (int)c3_.x, (int)c3_.y, (int)c3_.z, (int)c3_.w}; } while (0)
#define P7X_DMA() do { _Pragma("unroll") for (int i = 0; i < 16; ++i) __builtin_amdgcn_raw_ptr_buffer_load_lds(rsrc, (LAS void*)(rowbuf + i * 1024), 16, (int)(ea[i >> 2][i & 3] * 128u) + ((i & 1) ? pc1 : pc0), so_w, 0, 0); } while (0)
            P7X_IDX(t0);
            P7X_HX(); P7X_BLD();
            P7X_DMA();
            P7X_IDX(t0 + 1);
            __builtin_amdgcn_raw_buffer_store_b32(0u, rsrc, lane * 4, (int)WS_CTL + 950 * 1024, 0);
#pragma unroll 1
            for (int v = 0; v < P7_TB; ++v) {
                if (v == 0) asm volatile("s_waitcnt vmcnt(0)" ::: "memory"); else asm volatile("s_waitcnt vmcnt(1)" ::: "memory");
                if (v + 1 < P7_TB) P7X_HX();
                f32x4 acc0 = {0.f, 0.f, 0.f, 0.f}, acc1 = {0.f, 0.f, 0.f, 0.f};
#pragma unroll
                for (int G_ = 0; G_ < 8; ++G_) {
                    const u32x4 a0 = *(const LAS u32x4*)(rowbuf + G_ * 2048 + rd0), a1 = *(const LAS u32x4*)(rowbuf + G_ * 2048 + rd1);
                    if (G_ & 1) {
                        acc1 = __builtin_amdgcn_mfma_scale_f32_16x16x128_f8f6f4(p7x_a8(a0), B0, acc1, 4, 0, 0, 0x7F7F7F7F, 0, scg[G_]); acc1 = __builtin_amdgcn_mfma_scale_f32_16x16x128_f8f6f4(p7x_a8(a1), B1, acc1, 4, 0, 0, 0x7F7F7F7F, 0, scg[G_]);
                        acc1 = __builtin_amdgcn_mfma_scale_f32_16x16x128_f8f6f4(p7x_a8(a0), B2, acc1, 4, 0, 0, 0x7F7F7F7F, 0, scg[G_]); acc1 = __builtin_amdgcn_mfma_scale_f32_16x16x128_f8f6f4(p7x_a8(a1), B3, acc1, 4, 0, 0, 0x7F7F7F7F, 0, scg[G_]);
                    } else {
                        acc0 = __builtin_amdgcn_mfma_scale_f32_16x16x128_f8f6f4(p7x_a8(a0), B0, acc0, 4, 0, 0, 0x7F7F7F7F, 0, scg[G_]); acc0 = __builtin_amdgcn_mfma_scale_f32_16x16x128_f8f6f4(p7x_a8(a1), B1, acc0, 4, 0, 0, 0x7F7F7F7F, 0, scg[G_]);
                        acc0 = __builtin_amdgcn_mfma_scale_f32_16x16x128_f8f6f4(p7x_a8(a0), B2, acc0, 4, 0, 0, 0x7F7F7F7F, 0, scg[G_]); acc0 = __builtin_amdgcn_mfma_scale_f32_16x16x128_f8f6f4(p7x_a8(a1), B3, acc0, 4, 0, 0, 0x7F7F7F7F, 0, scg[G_]);
                    }
                }
                if (v + 1 < P7_TB) { P7X_BLD(); asm volatile("s_waitcnt lgkmcnt(0)" ::: "memory"); P7X_DMA(); }
                { const int vn = v + 2 < P7_TB ? v + 2 : P7_TB - 1; P7X_IDX(t0 + vn); }
                const int so_p = (int)WS_PART + ((s * M + t0 + v) * 128) * 2;
                u32x2 o_; o_.x = pk2(acc0[0] + acc1[0], acc0[1] + acc1[1]); o_.y = pk2(acc0[2] + acc1[2], acc0[3] + acc1[3]);
                __builtin_amdgcn_raw_buffer_store_b64(o_, rsrc, vo_p, so_p, 0);
            }
            asm volatile("s_waitcnt vmcnt(0)" ::: "memory");
#undef P7X_IDX
#undef P7X_HX
#undef P7X_BLD
#undef P7X_DMA
        }
    }
}
template <int NT>
__device__ __forceinline__ void p7y_tokens(const Args& A, int tb, int tstride, int lane) {
    unsigned char* ws = A.ws;
    const float* SCU = (const float*)(ws + WS_SCU);
    int jj[2];
#pragma unroll
    for (int x = 0; x < 2; ++x) { const int R_ = 2 * lane + x; jj[x] = 16 * (R_ & 7) + (R_ >> 3); }
    int iv0[NT], iv1[NT]; float gw0[NT], gw1[NT]; unsigned pw[NT][8];
#pragma unroll
    for (int n = 0; n < NT; ++n) { const int t = tb + n * tstride;
        const int* ip = (const int*)(ws + WS_IDX) + (size_t)t * 128; const float* gp = (const float*)(ws + WS_GW) + (size_t)t * 128;
        iv0[n] = ip[jj[0]]; iv1[n] = ip[jj[1]]; gw0[n] = gp[jj[0]]; gw1[n] = gp[jj[1]];
        const unsigned* pp = (const unsigned*)(ws + WS_PART) + (size_t)t * 64 + lane;
#pragma unroll
        for (int s = 0; s < 8; ++s) pw[n][s] = pp[(size_t)s * M * 64]; }
    u32x4 sa[NT], sb[NT]; float su0[NT], su1[NT];
#pragma unroll
    for (int n = 0; n < NT; ++n) { sa[n] = *(const u32x4*)(ws + WS_WDS + (size_t)iv0[n] * 16); sb[n] = *(const u32x4*)(ws + WS_WDS + (size_t)iv1[n] * 16); su0[n] = SCU[iv0[n]]; su1[n] = SCU[iv1[n]]; }
#pragma unroll
    for (int n = 0; n < NT; ++n) { const int t = tb + n * tstride;
        float dv0 = 0.f, dv1 = 0.f;
#pragma unroll
        for (int s = 0; s < 8; ++s) { const unsigned a_ = sa[n][s >> 1], b_ = sb[n][s >> 1];
            dv0 += bf_lo(pw[n][s]) * ((s & 1) ? bf_hi(a_) : bf_lo(a_)); dv1 += bf_hi(pw[n][s]) * ((s & 1) ? bf_hi(b_) : bf_lo(b_)); }
        const float c0 = gelu_tanh(dv0) * (gw0[n] * su0[n]), c1 = gelu_tanh(dv1) * (gw1[n] * su1[n]);
        const int hi_ = __builtin_amdgcn_cvt_pk_fp8_f32(64.0f * c0, 64.0f * c1, 0, false);
        const int lo_ = __builtin_amdgcn_cvt_pk_fp8_f32(64.0f * c0 - __builtin_amdgcn_cvt_f32_fp8(hi_, 0), 64.0f * c1 - __builtin_amdgcn_cvt_f32_fp8(hi_, 1), 0, false);
        unsigned char* cb = ws + WS_CB + (size_t)t * 256;
        const int rho0 = 8 * (jj[0] & 15) + (jj[0] >> 4), rho1 = 8 * (jj[1] & 15) + (jj[1] >> 4);
        cb[rho0] = (unsigned char)(hi_ & 255); cb[rho1] = (unsigned char)((hi_ >> 8) & 255); cb[128 + rho0] = (unsigned char)(lo_ & 255); cb[128 + rho1] = (unsigned char)((lo_ >> 8) & 255);
    }
}
__device__ __forceinline__ void p8x_wave(const Args& A, LAS unsigned char* lds, int wave, int lane_, int qset) {
    unsigned char* ws = A.ws;
    typedef int v2i_ __attribute__((ext_vector_type(2)));
    const __amdgpu_buffer_rsrc_t rsrc = __builtin_amdgcn_make_buffer_rsrc((void*)ws, 0, 0x7FFFFFFF, 0x00020000);
    int lane = lane_; asm volatile("" : "+v"(lane));
    LAS unsigned char* rowbuf = lds + wave * 16384;
    const int i16 = lane & 15, g = lane >> 4, l3 = lane >> 3, ih = i16 >> 1;
    const int rb = (32 * g + i16) * 128;
    const int pc0 = ((lane & 7) ^ (l3 >> 1)) << 4, pc1 = ((lane & 7) ^ (4 + (l3 >> 1))) << 4;
    const int vo_a = l3 * 64, vo_b = g * 16, vo_o = (i16 * 16 + g * 4) * 2;
    int scm[16];
#pragma unroll
    for (int m = 0; m < 16; ++m) scm[m] = (i16 == m) ? 0x79797979 : 0;
    int offp[8];
#pragma unroll
    for (int p = 0; p < 8; ++p) offp[p] = rb + ((p ^ ih) << 4);
    unsigned* Q = (unsigned*)(ws + WS_CTL + CTL_P7Q) + qset * 512;
    const int xs = (int)(xb_xcc_id() & 7u);
#pragma unroll 1
    for (int k = 0; k < 8; ++k) {
        const int s = (xs + k) & 7;
        const int so_w = (int)WS_WU4 + s * (16384 * 128);
#pragma unroll 1
        for (;;) {
            unsigned blk = 0u; if (lane == 0) blk = xb_add(Q + s * 64, 1u);
            blk = (unsigned)__builtin_amdgcn_readfirstlane((int)blk);
            if (blk >= (unsigned)(M / P7_TB)) break;
            const int t0 = (int)blk * P7_TB;
            u32x4 ea[4]; i32x8 Bh, Bl;
#define P8X_IDX(tt) do { const int so_ = (int)WS_IDX + (tt) * 512; \
            _Pragma("unroll") for (int q_ = 0; q_ < 4; ++q_) ea[q_] = __builtin_bit_cast(u32x4, __builtin_amdgcn_raw_buffer_load_b128(rsrc, vo_a + 16 * q_, so_, 0)); } while (0)
#define P8X_BLD(tt) do { const int so_ = (int)WS_CB + (tt) * 256; \
            const u32x4 b0_ = __builtin_bit_cast(u32x4, __builtin_amdgcn_raw_buffer_load_b128(rsrc, vo_b, so_, 0)), b1_ = __builtin_bit_cast(u32x4, __builtin_amdgcn_raw_buffer_load_b128(rsrc, vo_b + 64, so_, 0)); \
            const u32x4 c0_ = __builtin_bit_cast(u32x4, __builtin_amdgcn_raw_buffer_load_b128(rsrc, vo_b + 128, so_, 0)), c1_ = __builtin_bit_cast(u32x4, __builtin_amdgcn_raw_buffer_load_b128(rsrc, vo_b + 192, so_, 0)); \
            Bh = (i32x8){(int)b0_.x, (int)b0_.y, (int)b0_.z, (int)b0_.w, (int)b1_.x, (int)b1_.y, (int)b1_.z, (int)b1_.w}; \
            Bl = (i32x8){(int)c0_.x, (int)c0_.y, (int)c0_.z, (int)c0_.w, (int)c1_.x, (int)c1_.y, (int)c1_.z, (int)c1_.w}; } while (0)
#define P8X_DMA() do { _Pragma("unroll") for (int i = 0; i < 16; ++i) __builtin_amdgcn_raw_ptr_buffer_load_lds(rsrc, (LAS void*)(rowbuf + i * 1024), 16, (int)(ea[i >> 2][i & 3] * 128u) + ((i & 1) ? pc1 : pc0), so_w, 0, 0); } while (0)
            P8X_IDX(t0);
            P8X_BLD(t0);
            P8X_DMA();
            P8X_IDX(t0 + 1);
            __builtin_amdgcn_raw_buffer_store_b32(0u, rsrc, lane * 4, (int)WS_CTL + 950 * 1024, 0);
#pragma unroll 1
            for (int v = 0; v < P7_TB; ++v) {
                if (v == 0) asm volatile("s_waitcnt vmcnt(0)" ::: "memory"); else asm volatile("s_waitcnt vmcnt(1)" ::: "memory");
                f32x4 acc0 = {0.f, 0.f, 0.f, 0.f}, acc1 = {0.f, 0.f, 0.f, 0.f};
#pragma unroll
                for (int m = 0; m < 16; ++m) {
                    const v2i_ r0 = __builtin_amdgcn_ds_read_tr4_b64_v2i32((LAS v2i_*)(rowbuf + offp[m >> 1] + (m & 1) * 8)), r1 = __builtin_amdgcn_ds_read_tr4_b64_v2i32((LAS v2i_*)(rowbuf + offp[m >> 1] + 2048 + (m & 1) * 8));
                    const i32x8 a_ = (i32x8){r0.x, r0.y, r1.x, r1.y, 0, 0, 0, 0};
                    if (m & 1) { acc1 = __builtin_amdgcn_mfma_scale_f32_16x16x128_f8f6f4(a_, Bh, acc1, 4, 0, 0, 0x7F7F7F7F, 0, scm[m]); acc1 = __builtin_amdgcn_mfma_scale_f32_16x16x128_f8f6f4(a_, Bl, acc1, 4, 0, 0, 0x7F7F7F7F, 0, scm[m]); }
                    else         { acc0 = __builtin_amdgcn_mfma_scale_f32_16x16x128_f8f6f4(a_, Bh, acc0, 4, 0, 0, 0x7F7F7F7F, 0, scm[m]); acc0 = __builtin_amdgcn_mfma_scale_f32_16x16x128_f8f6f4(a_, Bl, acc0, 4, 0, 0, 0x7F7F7F7F, 0, scm[m]); }
                }
                if (v + 1 < P7_TB) { asm volatile("s_waitcnt lgkmcnt(0)" ::: "memory"); P8X_DMA(); P8X_BLD(t0 + v + 1); }
                { const int vn = v + 2 < P7_TB ? v + 2 : P7_TB - 1; P8X_IDX(t0 + vn); }
                u32x2 o_; o_.x = pk2(acc0[0] + acc1[0], acc0[1] + acc1[1]); o_.y = pk2(acc0[2] + acc1[2], acc0[3] + acc1[3]);
                __builtin_amdgcn_raw_buffer_store_b64(o_, rsrc, vo_o, (int)WS_PO + ((t0 + v) * 2048 + 256 * s) * 2, 0);
            }
            asm volatile("s_waitcnt vmcnt(0)" ::: "memory");
#undef P8X_IDX
#undef P8X_BLD
#undef P8X_DMA
        }
    }
}
__device__ __forceinline__ void p7c_token(const Args& A, int t, int lane) {
    float* orow = A.out + (size_t)t * 2048; const bf16_t* prow = (const bf16_t*)(A.ws + WS_PO) + (size_t)t * 2048; const bf16_t* xrow = (const bf16_t*)(A.ws + WS_GA) + (size_t)t * 2048; const float* g = A.in[18];
    f32x4 y[8]; float s2 = 0.f;
#pragma unroll
    for (int j = 0; j < 4; ++j) { const u32x4 p = *(const u32x4*)(prow + 512 * j + 8 * lane), x = *(const u32x4*)(xrow + 512 * j + 8 * lane);
        y[2 * j] = (f32x4){bf_lo(p.x) + bf_lo(x.x), bf_hi(p.x) + bf_hi(x.x), bf_lo(p.y) + bf_lo(x.y), bf_hi(p.y) + bf_hi(x.y)};
        y[2 * j + 1] = (f32x4){bf_lo(p.z) + bf_lo(x.z), bf_hi(p.z) + bf_hi(x.z), bf_lo(p.w) + bf_lo(x.w), bf_hi(p.w) + bf_hi(x.w)};
        s2 += (y[2 * j].x * y[2 * j].x + y[2 * j].y * y[2 * j].y) + (y[2 * j].z * y[2 * j].z + y[2 * j].w * y[2 * j].w) + (y[2 * j + 1].x * y[2 * j + 1].x + y[2 * j + 1].y * y[2 * j + 1].y) + (y[2 * j + 1].z * y[2 * j + 1].z + y[2 * j + 1].w * y[2 * j + 1].w); }
    const float rs2 = __builtin_amdgcn_rsqf(dpp_sum(s2) * (1.0f / 2048.0f) + EPS);
#pragma unroll
    for (int j = 0; j < 4; ++j) { const f32x4 g0 = *(const f32x4*)(g + 512 * j + 8 * lane), g1 = *(const f32x4*)(g + 512 * j + 8 * lane + 4);
        *(f32x4*)(orow + 512 * j + 8 * lane) = y[2 * j] * rs2 * g0; *(f32x4*)(orow + 512 * j + 8 * lane + 4) = y[2 * j + 1] * rs2 * g1; }
}

__global__ void __launch_bounds__(NWAVES * 64, 2) fwd(Args args) {
    extern __shared__ __attribute__((aligned(16))) unsigned char lds_raw[];
    LAS unsigned char* lds = (LAS unsigned char*)lds_raw;
    const int tid = threadIdx.x, lane = tid & 63, wave = __builtin_amdgcn_readfirstlane(tid >> 6);
    const int G = gridDim.x; const int bx = blockIdx.x; const int vcu = (G % 8 == 0) ? (bx % 8) * (G / 8) + bx / 8 : bx;
    unsigned char* ws = args.ws;
    unsigned* ctl = (unsigned*)(ws + WS_CTL);
    for (int u = tid; u < (LDS_BYTES - LDSCTL_OFF) / 4; u += NWAVES * 64) ((LAS unsigned*)(lds + LDSCTL_OFF))[u] = 0u;
    __syncthreads();
    const int lo = args.ph_lo, hi = args.ph_hi;
    const XcdBarrier bar = xcd_barrier_post(ctl + CW_BAR + args.li * XCD_BAR_WORDS, (volatile LAS unsigned*)(lds + LDSCTL_OFF + 64));
#define IN(k) (((PH_MASK >> (k)) & 1) && lo <= (k) && (k) < hi)
#define BOTH(k) (IN(k) && IN((k) + 1))
#define GRID_BAR() xcd_barrier(bar)

    if (IN(0)) { p0_prologue(args, lds, vcu, G, wave, lane, tid); if (BOTH(0)) GRID_BAR(); }

    if (IN(1)) {
        const bool split = G > 64;
        if (!split || bx < 32) { SchedP1 S{G, bx, (unsigned)WS_H1, (unsigned)WS_WIN, (unsigned)WS_MEMN, (unsigned)WS_WKV, 0, 32};
            EpiP1 E{(bf16_t*)(ws + WS_GA), (bf16_t*)(ws + WS_BG), (bf16_t*)(ws + WS_CH), (bf16_t*)(ws + WS_KF), (bf16_t*)(ws + WS_VF)};
            pg8::gemm_phase<EpiP1, SchedP1>(lds, ws, 2048, S, E); }
        if (!split) p0b_convert(args, lds, vcu, G, wave, lane);
        else if (bx >= 32) p0b_convert(args, lds, bx - 32, G - 32, wave, lane);
        if (BOTH(1)) GRID_BAR();
    }

    if (IN(2)) {
        { SchedP1F S{G, bx, (unsigned)WS_H8, (unsigned)WS_W8};
          EpiP1F E{(bf16_t*)(ws + WS_GA), (bf16_t*)(ws + WS_BG), (bf16_t*)(ws + WS_CH), (bf16_t*)(ws + WS_Q), ws + WS_SG8, (const float*)(ws + WS_HS), (const unsigned*)(ws + WS_CTL + CTL_CMX)};
          pg8::gemm_phase<EpiP1F, SchedP1F, 2>(lds, ws, 1024, S, E); }
        if (BOTH(2)) GRID_BAR();
    }

    if (IN(3)) {
        _Pragma("unroll 1") for (int rep = 0; rep < P2_REP_G; ++rep) { asm volatile("" ::: "memory"); for (int blk = vcu; blk < M / 128; blk += G) p2_gmlp_block(args, lds, blk, wave, lane, tid); }
        _Pragma("unroll 1") for (int rep = 0; rep < P2_REP_C; ++rep) { asm volatile("" ::: "memory"); p2_conv(args, vcu, G, tid); }
        _Pragma("unroll 1") for (int rep = 0; rep < P2_REP_A; ++rep) { asm volatile("" ::: "memory"); for (int a = vcu; a < 512; a += G) { const int b = a >> 7, h = (a >> 5) & 3, qt = a & 31; p2_attn_unit(args, lds, b, h, qt * 256 + wave * 32, lane, tid); } __syncthreads(); }
        if (BOTH(3)) GRID_BAR();
    }

    if (IN(4)) {
        SchedP3 S{G, bx};
        EpiP3 E{(bf16_t*)(ws + WS_H1), ws + WS_SG8};
        pg8::gemm_phase<EpiP3, SchedP3>(lds, ws, 1024, S, E);
        if (BOTH(4)) GRID_BAR();
    }

    if (IN(5)) {
        SchedSimple S{G, bx, 128, 8, (unsigned)WS_H1, (unsigned)WS_WOUT};
        EpiP4 E{args.in[0], args.out, (bf16_t*)(ws + WS_GA), (float*)(ws + WS_SSP)};
        pg8::gemm_phase<EpiP4, SchedSimple>(lds, ws, 2048, S, E);
        if (BOTH(5)) GRID_BAR();
    }

    if (IN(6)) {
        SchedSimple S{G, bx, 128, 8, (unsigned)WS_GA, (unsigned)WS_WQ};
        EpiBf E{(bf16_t*)(ws + WS_PQ)};
        pg8::gemm_phase<EpiBf, SchedSimple>(lds, ws, 2048, S, E);
        if (BOTH(6)) GRID_BAR();
    }

    if (IN(7)) {
        for (int it = vcu; it < 256; it += G) {
            const int head = it & 7, chunk = it >> 3;
            __syncthreads();
            {
                const u32x4* src = (const u32x4*)(ws + WS_KEYF) + (size_t)head * 4096;
#pragma unroll
                for (int j = 0; j < 8; ++j) *(LAS u32x4*)(lds + (size_t)(j * 512 + tid) * 16) = src[j * 512 + tid];
            }
            __syncthreads();
#pragma unroll 1
            for (int q = 0; q < 4; ++q) { asm volatile("" ::: "memory"); p6_tile(args, lds, head, chunk * 1024 + (q * 8 + wave) * 32, lane); }
        }
        if (BOTH(7)) GRID_BAR();
    }

    if (IN(8)) {
        _Pragma("unroll 1") for (int rep = 0; rep < P7X_REP; ++rep) { asm volatile("" ::: "memory"); p7x_wave(args, lds, wave, lane, args.li * 4 + rep); GRID_BAR(); }
        _Pragma("unroll 1") for (int rep = 0; rep < P7Y_REP; ++rep) { asm volatile("" ::: "memory");
            if (M % (G * NWAVES * 4) == 0) { _Pragma("unroll 1") for (int t = vcu * NWAVES + wave; t < M; t += G * NWAVES * 4) p7y_tokens<4>(args, t, G * NWAVES, lane); }
            else { _Pragma("unroll 1") for (int t = vcu * NWAVES + wave; t < M; t += G * NWAVES) p7y_tokens<1>(args, t, G * NWAVES, lane); } }
        GRID_BAR();
        _Pragma("unroll 1") for (int rep = 0; rep < P8X_REP; ++rep) { asm volatile("" ::: "memory"); p8x_wave(args, lds, wave, lane, args.li * 4 + 2 + rep); if (rep + 1 < P8X_REP) GRID_BAR(); }
        if (BOTH(8)) GRID_BAR();
    }
    if (IN(9)) {
        for (int t = vcu * NWAVES + wave; t < M; t += G * NWAVES) p7c_token(args, t, lane);
    }
#undef IN
#undef BOTH
#undef GRID_BAR
}

extern "C" void kernel_launch(void* const* d_in, const int* in_sizes, int n_in, void* d_out, int out_size, void* d_ws, size_t ws_size, hipStream_t stream) {
    static int grid = 0;
    if (grid == 0) {
        if (n_in != 19 || out_size != M * D || ws_size < WS_END) { fprintf(stderr, "kernel_launch: unexpected shapes (n_in %d out %d ws %zu)\n", n_in, out_size, ws_size); grid = -1; return; }
        int dev = 0, cus = 0, per_cu = 0;
        if (hipGetDevice(&dev) != hipSuccess || hipDeviceGetAttribute(&cus, hipDeviceAttributeMultiprocessorCount, dev) != hipSuccess) { grid = -1; return; }
        if (hipFuncSetAttribute((const void*)fwd, hipFuncAttributeMaxDynamicSharedMemorySize, LDS_BYTES) != hipSuccess) { fprintf(stderr, "kernel_launch: hipFuncSetAttribute failed\n"); grid = -1; return; }
        if (hipOccupancyMaxActiveBlocksPerMultiprocessor(&per_cu, (const void*)fwd, NWAVES * 64, LDS_BYTES) != hipSuccess || per_cu < 1) { fprintf(stderr, "kernel_launch: occupancy query says %d\n", per_cu); }
        (void)hipGetLastError();
        grid = cus;
    }
    if (grid < 0) return;
    (void)hipMemsetAsync((char*)d_ws + WS_CTL, 0, CTL_ZERO_BYTES, stream);
    Args a{};
    for (int i = 0; i < 19; ++i) a.in[i] = (const float*)d_in[i];
    a.out = (float*)d_out; a.ws = (unsigned char*)d_ws;
#if MK_SPLIT
    static const int seq[] = MK_SEQ;
    for (int i = 0; i < (int)(sizeof(seq) / sizeof(seq[0])); ++i) { a.ph_lo = seq[i]; a.ph_hi = seq[i] + 1; a.li = i; hipLaunchKernelGGL(fwd, dim3(grid), dim3(NWAVES * 64), LDS_BYTES, stream, a); }
#else
    a.ph_lo = 0; a.ph_hi = NPHASE;
    hipLaunchKernelGGL(fwd, dim3(grid), dim3(NWAVES * 64), LDS_BYTES, stream, a);
#endif
}
```

```cpp
#include <hip/hip_runtime.h>
#include <cstdio>
#include <cstdint>

#ifndef MK_SPLIT
#define MK_SPLIT 0
#endif
#ifndef PH_MASK
#define PH_MASK 0x3FF
#endif
#ifndef MK_SEQ
#define MK_SEQ {0, 1, 2, 3, 4, 5, 6, 7, 8, 9}
#endif
#ifndef P2_REP_G
#define P2_REP_G 1
#endif
#ifndef P2_REP_C
#define P2_REP_C 1
#endif
#ifndef P2_REP_A
#define P2_REP_A 1
#endif
#ifndef P8X_REP
#define P8X_REP 1
#endif
#ifndef P7Y_REP
#define P7Y_REP 1
#endif
#ifndef P7X_REP
#define P7X_REP 1
#endif

#define LAS __attribute__((address_space(3)))
#define GAS __attribute__((address_space(1)))
typedef unsigned short bf16_t;
typedef short bf16x8 __attribute__((ext_vector_type(8)));
typedef float f32x2 __attribute__((ext_vector_type(2)));
typedef float f32x4 __attribute__((ext_vector_type(4)));
typedef float f32x16 __attribute__((ext_vector_type(16)));
typedef unsigned u32x2 __attribute__((ext_vector_type(2)));
typedef unsigned u32x4 __attribute__((ext_vector_type(4)));
typedef __bf16 bf16x2_t __attribute__((ext_vector_type(2)));
typedef unsigned u32x16 __attribute__((ext_vector_type(16)));
typedef int i32x4 __attribute__((ext_vector_type(4)));
typedef unsigned u32x6 __attribute__((ext_vector_type(6)));
typedef unsigned u32x3 __attribute__((ext_vector_type(3)));
typedef float f32x32 __attribute__((ext_vector_type(32)));
typedef int i32x8 __attribute__((ext_vector_type(8)));

constexpr int BATCH = 4, SEQ = 8192, D = 2048, M = BATCH * SEQ, NMEM = 256, MM = BATCH * NMEM;
constexpr int DIN = 12288;
constexpr float EPS = 1e-6f;
constexpr int NWAVES = 8;
constexpr int NPHASE = 10;

constexpr size_t MiB = 1u << 20;
constexpr size_t WS_CTL = 0, CTL_ZERO_BYTES = 1 * MiB;
constexpr size_t WS_SSP = 1 * MiB;
constexpr size_t WS_WIN = 5 * MiB;
constexpr size_t WS_WKV = 53 * MiB;
constexpr size_t WS_WB = 61 * MiB;
constexpr size_t WS_WOUT = 73 * MiB;
constexpr size_t WS_WQ = 81 * MiB;
constexpr size_t WS_KEYF = 89 * MiB;
constexpr size_t WS_WSM = 89 * MiB + 512 * 1024;
constexpr size_t WS_MEMN = 90 * MiB;
constexpr size_t WS_KF = 94 * MiB;
constexpr size_t WS_VF = 96 * MiB;
constexpr size_t WS_SCU = 162 * MiB + 65536;
constexpr size_t WS_H1 = 226 * MiB;
constexpr size_t WS_GA = 354 * MiB;
constexpr size_t WS_BG = 482 * MiB;
constexpr size_t WS_CH = 546 * MiB;
constexpr size_t WS_Q = 610 * MiB;
constexpr size_t WS_SG8 = 674 * MiB;
constexpr size_t WS_PQ = 674 * MiB;
constexpr size_t WS_IDX = 802 * MiB;
constexpr size_t WS_GW = 818 * MiB;
constexpr size_t WS_YC = 930 * MiB;
constexpr size_t WS_PO = 226 * MiB;
constexpr size_t WS_YA = 866 * MiB;
constexpr size_t WS_H8 = 930 * MiB;
constexpr size_t WS_END = 994 * MiB;
constexpr size_t WS_W8 = 25 * MiB;
constexpr size_t WS_HS = 162 * MiB + 131072;
constexpr size_t WS_WU4 = 130 * MiB;
constexpr size_t WS_CB = 834 * MiB;
constexpr size_t WS_WD4 = 98 * MiB;
constexpr size_t WS_WDS = 114 * MiB;
constexpr size_t WS_PART = 482 * MiB;
constexpr size_t WS_RA = 162 * MiB + 524288;
constexpr size_t WS_A80 = 290 * MiB, WS_A81 = 322 * MiB, WS_A82 = 354 * MiB;
constexpr size_t WS_RS = 162 * MiB + 262144;
constexpr size_t CTL_P7Q = 768 * 1024;
constexpr size_t CTL_CNT3 = 600 * 1024;
constexpr size_t CTL_RM = 608 * 1024;
constexpr size_t CTL_CMXB = 264 * 1024;
constexpr size_t CTL_CMXQ = 584 * 1024;
constexpr size_t CTL_CMXO = 576 * 1024;
constexpr size_t CTL_CMX = 512 * 1024;
constexpr int CW_TMO = 0, CW_BAR = 4096;

constexpr int RING_BYTES = 131072, LDSCTL_OFF = RING_BYTES, LDS_BYTES = 159744;

__device__ __forceinline__ unsigned pk2(float lo, float hi) { f32x2 v = {lo, hi}; bf16x2_t b = __builtin_convertvector(v, bf16x2_t); return __builtin_bit_cast(unsigned, b); }
__device__ __forceinline__ float bf_lo(unsigned u) { return __uint_as_float(u << 16); }
__device__ __forceinline__ float bf_hi(unsigned u) { return __uint_as_float(u & 0xffff0000u); }
__device__ __forceinline__ float gelu_tanh(float x) {
    const float t = x * (1.0f + 0.044715f * x * x) * (-2.302208198f);
    return x * __builtin_amdgcn_rcpf(1.0f + __builtin_amdgcn_exp2f(t));
}
__device__ __forceinline__ float sigmoidf_(float x) { return __builtin_amdgcn_rcpf(1.0f + __builtin_amdgcn_exp2f(x * -1.44269504f)); }
__device__ __forceinline__ float wave_sum(float v) {
#pragma unroll
    for (int o = 1; o < 64; o <<= 1) v += __shfl_xor(v, o);
    return v;
}
#define MFMA32(a, b, c) __builtin_amdgcn_mfma_f32_32x32x16_bf16((a), (b), (c), 0, 0, 0)

namespace pg8 {
constexpr int BM = 256, BK = 64, HALF = 128, HTB = HALF * BK * 2, STAGE_BYTES = 8 * HTB;
__host__ __device__ __forceinline__ int lds_byte(int r, int c) { const int st = (r >> 4) * 2 + (c >> 5), rr = r & 15, cc = c & 31, ob = rr * 64 + cc * 2; return st * 1024 + (ob ^ (((ob >> 9) & 1) << 5)); }
__host__ __device__ __forceinline__ void stage_rc(int b, int& R, int& C) { const int st = b / 1024, sb = b % 1024, swz = sb ^ (((sb >> 9) & 1) << 5); R = (st >> 1) * 16 + swz / 64; C = (st & 1) * 32 + (swz % 64) / 2; }
__host__ __device__ __forceinline__ int perm32(int rho) { const int n = rho >> 4, i = rho & 15; return 8 * (i >> 2) + 4 * n + (i & 3); }

struct Unit { int pm, pn, kind, aux; unsigned a, b; };

__device__ __forceinline__ void tile_map(int L, int nM, int nN, int& pm, int& pn) {
    const int nwg = nM * nN; int wgid = L;
    { const int q = nwg / 8, r = nwg % 8, xcd = wgid % 8, off = wgid / 8; wgid = (xcd < r ? xcd * (q + 1) : r * (q + 1) + (xcd - r) * q) + off; }
    const int nig = 8 * nN, gid = wgid / nig, fm = gid * 8, gsz = (nM - fm) < 8 ? (nM - fm) : 8;
    pm = fm + ((wgid % nig) % gsz); pn = (wgid % nig) / gsz;
}

template <class Epi, class Sched, int MODE = 0>
__device__ __forceinline__ void gemm_phase(LAS unsigned char* lds, const unsigned char* wsbase, const int K, const Sched& S, const Epi& E) {
    const __amdgpu_buffer_rsrc_t rsrc = __builtin_amdgcn_make_buffer_rsrc((void*)wsbase, 0, 0x7FFFFFFF, 0x00020000);
    int tid = threadIdx.x; asm volatile("" : "+v"(tid));
    const int wid = __builtin_amdgcn_readfirstlane(tid >> 6), lane = tid & 63, wr = wid >> 2, wc = wid & 3, fr = lane & 15, fq = lane >> 4;
    const int nt = K / BK;
    unsigned voffA[2], voffB[2];
#pragma unroll
    for (int i = 0; i < 2; ++i) { int R, C; stage_rc(tid * 16 + i * 8192, R, C); const int Rb = (R & ~31) + perm32(R & 31);
        voffA[i] = (unsigned)(R * K + C) * 2u; voffB[i] = (unsigned)(Rb * K + C) * 2u; }
    const unsigned kstep = (unsigned)(BK * 2);
    const unsigned hstep = (unsigned)HALF * K * 2;
    const unsigned ldsw = (unsigned)wid * 1024u;
    const int aoff = lds_byte(wr * 64 + fr, fq * 8), boff = lds_byte(wc * 32 + fr, fq * 8);
#define PG8_SA(b, h) (((b) * 2 + (h)) * HTB)
#define PG8_SB(b, h) ((4 + (b) * 2 + (h)) * HTB)
#define PG8_STAGE(bufoff, gbase, voff) do { _Pragma("unroll") for (int _i = 0; _i < 2; ++_i) \
        __builtin_amdgcn_raw_ptr_buffer_load_lds(rsrc, (LAS void*)(lds + (bufoff) + ldsw + _i * 8192), 16, (int)(voff)[_i], (int)(gbase), 0, 0); } while (0)
#define PG8_LDA(dst, b, h) do { _Pragma("unroll") for (int m = 0; m < 4; ++m) _Pragma("unroll") for (int k = 0; k < 2; ++k) dst[m][k] = *(const LAS bf16x8*)(lds + PG8_SA(b, h) + aoff + m * 2048 + k * 1024); } while (0)
#define PG8_LDB(dst, b, h) do { _Pragma("unroll") for (int n = 0; n < 2; ++n) _Pragma("unroll") for (int k = 0; k < 2; ++k) dst[n][k] = *(const LAS bf16x8*)(lds + PG8_SB(b, h) + boff + n * 2048 + k * 1024); } while (0)
#define PG8_CAT(x) __builtin_shufflevector(__builtin_bit_cast(i32x4, x[0]), __builtin_bit_cast(i32x4, x[1]), 0, 1, 2, 3, 4, 5, 6, 7)
#define PG8_MMA(ai, bj, At, Bt) do { __builtin_amdgcn_s_setprio(1); _Pragma("unroll") for (int m = 0; m < 4; ++m) _Pragma("unroll") for (int n = 0; n < 2; ++n) { \
        if constexpr (MODE == 1) acc[ai][bj][m][n] = __builtin_amdgcn_mfma_scale_f32_16x16x128_f8f6f4(PG8_CAT(Bt[n]), PG8_CAT(At[m]), acc[ai][bj][m][n], 0, 0, 0, 0, 0, 0); \
        else if constexpr (MODE == 2) { _Pragma("unroll") for (int k = 0; k < 2; ++k) acc[ai][bj][m][n] = __builtin_bit_cast(f32x4, __builtin_amdgcn_mfma_i32_16x16x64_i8(__builtin_bit_cast(i32x4, Bt[n][k]), __builtin_bit_cast(i32x4, At[m][k]), __builtin_bit_cast(i32x4, acc[ai][bj][m][n]), 0, 0, 0)); } \
        else { _Pragma("unroll") for (int k = 0; k < 2; ++k) acc[ai][bj][m][n] = __builtin_amdgcn_mfma_f32_16x16x32_bf16(Bt[n][k], At[m][k], acc[ai][bj][m][n], 0, 0, 0); } } \
        __builtin_amdgcn_s_setprio(0); } while (0)
#define PG8_WAIT_V(n) asm volatile("s_waitcnt vmcnt(" #n ")" ::: "memory")
#define PG8_WAIT_L(n) asm volatile("s_waitcnt lgkmcnt(" #n ")" ::: "memory")
#define PG8_BAR __builtin_amdgcn_s_barrier()
#define PG8_SCHED __builtin_amdgcn_sched_barrier(0)
    Unit cur, nxt; int ui = 0;
    if (!S.next(0, cur)) return;
    f32x4 acc[2][2][4][2];
#pragma unroll
    for (int a = 0; a < 2; ++a)
#pragma unroll
        for (int b = 0; b < 2; ++b)
#pragma unroll
            for (int m = 0; m < 4; ++m)
#pragma unroll
                for (int n = 0; n < 2; ++n) acc[a][b][m][n] = (f32x4){0.f, 0.f, 0.f, 0.f};
    bf16x8 At[4][2], B0[2][2], B1[2][2];
    unsigned cA = cur.a, cB = cur.b;
    if constexpr (Epi::PRE) E.pre(lds, rsrc, cur, wid, lane);
    PG8_STAGE(PG8_SB(0, 0), cB, voffB); PG8_STAGE(PG8_SB(0, 1), cB + hstep, voffB); PG8_STAGE(PG8_SA(0, 0), cA, voffA); PG8_STAGE(PG8_SA(0, 1), cA + hstep, voffA);
    if (wr == 1) PG8_BAR;
    PG8_WAIT_V(2); PG8_BAR;
    PG8_STAGE(PG8_SB(1, 0), cB + kstep, voffB); PG8_STAGE(PG8_SA(1, 0), cA + kstep, voffA); PG8_STAGE(PG8_SB(1, 1), cB + hstep + kstep, voffB);
    PG8_WAIT_V(6); PG8_BAR;
    for (;;) {
        const bool has_next = S.next(ui + 1, nxt);
        const unsigned nA = has_next ? nxt.a : cA, nB = has_next ? nxt.b : cB;
        for (int t = 0; t < nt; t += 2) {
            const bool last = (t == nt - 2);
            const unsigned a1 = cA + (unsigned)(t + 1) * kstep;
            const unsigned a2 = last ? nA : cA + (unsigned)(t + 2) * kstep, b2 = last ? nB : cB + (unsigned)(t + 2) * kstep;
            const unsigned a3 = a2 + kstep, b3 = b2 + kstep;
            PG8_LDB(B0, 0, 0); PG8_LDB(B1, 0, 1); PG8_SCHED; PG8_LDA(At, 0, 0); PG8_STAGE(PG8_SA(1, 1), a1 + hstep, voffA);
            PG8_WAIT_V(8); PG8_WAIT_L(0); PG8_BAR; PG8_MMA(0, 0, At, B0); PG8_MMA(0, 1, At, B1); PG8_BAR; PG8_SCHED;
            PG8_LDA(At, 0, 1); PG8_STAGE(PG8_SB(0, 0), b2, voffB); PG8_STAGE(PG8_SB(0, 1), b2 + hstep, voffB); PG8_STAGE(PG8_SA(0, 0), a2, voffA);
            PG8_WAIT_V(8); PG8_WAIT_L(0); PG8_BAR; PG8_MMA(1, 0, At, B0); PG8_MMA(1, 1, At, B1); PG8_BAR; PG8_SCHED;
            PG8_LDB(B0, 1, 0); PG8_LDB(B1, 1, 1); PG8_SCHED; PG8_LDA(At, 1, 0); PG8_STAGE(PG8_SA(0, 1), a2 + hstep, voffA);
            PG8_WAIT_V(8); PG8_WAIT_L(0); PG8_BAR; PG8_MMA(0, 0, At, B0); PG8_MMA(0, 1, At, B1); PG8_BAR; PG8_SCHED;
            PG8_LDA(At, 1, 1); PG8_STAGE(PG8_SB(1, 0), b3, voffB); PG8_STAGE(PG8_SB(1, 1), b3 + hstep, voffB); PG8_STAGE(PG8_SA(1, 0), a3, voffA);
            PG8_WAIT_V(8); PG8_WAIT_L(0); PG8_BAR; PG8_MMA(1, 0, At, B0); PG8_MMA(1, 1, At, B1); PG8_BAR; PG8_SCHED;
        }
        if (wr == 0) PG8_BAR;
        E(acc, cur, wr, wc, fr, fq);
        if (!has_next) break;
        if constexpr (!Epi::CHAIN) {
#pragma unroll
        for (int a = 0; a < 2; ++a)
#pragma unroll
            for (int b = 0; b < 2; ++b)
#pragma unroll
                for (int m = 0; m < 4; ++m)
#pragma unroll
                    for (int n = 0; n < 2; ++n) acc[a][b][m][n] = (f32x4){0.f, 0.f, 0.f, 0.f};
        }
        cur = nxt; cA = nA; cB = nB; ++ui;
        if constexpr (Epi::PRE) E.pre(lds, rsrc, cur, wid, lane);
        if (wr == 1) PG8_BAR;
    }
    PG8_WAIT_V(0);
    PG8_BAR;
#undef PG8_SA
#undef PG8_SB
#undef PG8_STAGE
#undef PG8_LDA
#undef PG8_LDB
#undef PG8_MMA
#undef PG8_CAT
#undef PG8_WAIT_V
#undef PG8_WAIT_L
#undef PG8_BAR
#undef PG8_SCHED
}
}
using pg8::Unit;

#define XB_TMO      128
#define XB_XCNT(j)  (256  + 64 * (j))
#define XB_XSUB(j)  (1280 + 64 * (j))
#define XB_XGEN(j)  (2304 + 64 * (j))
#define XB_TOP      3328
#define XB_TOPGEN   3392
#define XCD_BAR_WORDS 3456
#define XB_SPIN_CAP (1u << 18)
__device__ __forceinline__ unsigned xb_ld(unsigned* p)              { return __hip_atomic_load(p, __ATOMIC_RELAXED, __HIP_MEMORY_SCOPE_AGENT); }
__device__ __forceinline__ unsigned xb_add(unsigned* p, unsigned v) { return __hip_atomic_fetch_add(p, v, __ATOMIC_RELAXED, __HIP_MEMORY_SCOPE_AGENT); }
__device__ __forceinline__ unsigned xb_xcc_id() { return (unsigned)__builtin_amdgcn_s_getreg((3 << 11) | 20) & 0xFu; }
#define XB_SPIN(cond, bar) do { unsigned _sp = 0; while (cond) { __builtin_amdgcn_s_sleep(1); \
    if ((++_sp & 255u) == 0u) { if (xb_ld(&(bar)[XB_TMO])) break; if (_sp > XB_SPIN_CAP) { atomicAdd(&(bar)[XB_TMO], 1u); break; } } } } while (0)
struct XcdBarrier { unsigned* bar; unsigned x; volatile LAS unsigned* st; };
__device__ __forceinline__ XcdBarrier xcd_barrier_post(unsigned* bar, volatile LAS unsigned* st) {
    XcdBarrier b; b.bar = bar; b.x = xb_xcc_id(); b.st = st;
    if (threadIdx.x == 0) (void)xb_add(&bar[XB_XCNT(b.x)], 1u);
    return b;
}
__device__ __forceinline__ void xcd_barrier_complete(unsigned* bar, unsigned x, unsigned& nloc, unsigned& nx) {
    const unsigned G = gridDim.x * gridDim.y * gridDim.z;
    unsigned sum, cnt, mine, sp = 0u;
    for (;;) {
        sum = 0u; cnt = 0u; mine = 0u;
#pragma unroll
        for (unsigned j = 0; j < 16; ++j) { const unsigned c = xb_ld(&bar[XB_XCNT(j)]); sum += c; cnt += (c > 0u) ? 1u : 0u; mine = (j == x) ? c : mine; }
        if (sum == G) break;
        __builtin_amdgcn_s_sleep(1);
        if ((++sp & 255u) == 0u) { if (xb_ld(&bar[XB_TMO])) break; if (sp > XB_SPIN_CAP) { atomicAdd(&bar[XB_TMO], 1u); break; } }
    }
    nloc = mine > 0u ? mine : 1u; nx = cnt > 0u ? cnt : 1u;
}
__device__ __forceinline__ void xcd_barrier(const XcdBarrier& b) {
    asm volatile("s_waitcnt vmcnt(0)" ::: "memory");
    __syncthreads();
    if (threadIdx.x == 0) {
        unsigned* bar = b.bar;
        __builtin_amdgcn_s_waitcnt(0);
        unsigned nloc = b.st[0], nx = b.st[1];
        if (nloc == 0u) { xcd_barrier_complete(bar, b.x, nloc, nx); b.st[0] = nloc; b.st[1] = nx; }
        const unsigned old = xb_add(&bar[XB_XSUB(b.x)], 1u);
        const unsigned gen = old / nloc;
        if (old + 1u == (gen + 1u) * nloc) {
            __builtin_amdgcn_fence(__ATOMIC_RELEASE, "agent");
            asm volatile("s_waitcnt vmcnt(0)" ::: "memory");
            const unsigned og = xb_add(&bar[XB_TOP], 1u);
            const unsigned tg = og / nx;
            if (og + 1u == (tg + 1u) * nx) xb_add(&bar[XB_TOPGEN], 1u);
            else XB_SPIN(xb_ld(&bar[XB_TOPGEN]) == tg, bar);
            __builtin_amdgcn_fence(__ATOMIC_ACQUIRE, "agent");
            xb_add(&bar[XB_XGEN(b.x)], 1u);
            asm volatile("s_waitcnt vmcnt(0)" ::: "memory");
        } else {
            XB_SPIN(xb_ld(&bar[XB_XGEN(b.x)]) == gen, bar);
            __builtin_amdgcn_fence(__ATOMIC_ACQUIRE, "agent");
            asm volatile("s_waitcnt vmcnt(0)" ::: "memory");
        }
    }
    __syncthreads();
}

constexpr unsigned TSTEP2048 = 256u * 2048u * 2u, TSTEP1024 = 256u * 1024u * 2u;
struct SchedP1 {
    int G, c; unsigned H1, WIN, MEMN, WKV; int first, count;
    __device__ __forceinline__ bool next(int i, Unit& u) const {
        const int Lr = i * G + c, L = first + Lr;
        if (Lr >= count) return false;
        const bool kv = L < 32;
        const unsigned isv = (unsigned)(L >> 4) & 1u, j = (unsigned)(L & 15);
        const unsigned ak = MEMN + (j >> 2) * TSTEP2048, bk = WKV + (j & 3) * TSTEP2048, av = WKV + (4u + (j >> 2)) * TSTEP2048, bv = MEMN + (j & 3) * TSTEP2048;
        int pm, pn; pg8::tile_map(kv ? 0 : L - 32, 128, 20, pm, pn);
        const int kt = pn < 8 ? 0 : (pn < 12 ? 1 : 2);
        u.pm = kv ? (int)(j >> 2) : pm; u.pn = kv ? (int)(j & 3) : pn; u.kind = kv ? 5 + (int)isv : kt; u.aux = 0;
        u.a = kv ? ak + isv * (av - ak) : H1 + (unsigned)pm * TSTEP2048;
        u.b = kv ? bk + isv * (bv - bk) : WIN + (unsigned)pn * TSTEP2048;
        return true;
    }
};
struct SchedP1F {
    int G, c; unsigned H8, W8;
    __device__ __forceinline__ bool next(int i, Unit& u) const {
        const int L = i * G + c;
        if (L >= 128 * 48) return false;
        pg8::tile_map(L, 128, 48, u.pm, u.pn);
        u.a = H8 + (unsigned)u.pm * TSTEP1024; u.b = W8 + (unsigned)u.pn * TSTEP1024;
        u.kind = u.pn < 8 ? 0 : (u.pn < 12 ? 1 : (u.pn < 20 ? 2 : (u.pn < 24 ? 3 : 4))); u.aux = i & 1;
        return true;
    }
};
struct SchedP3 {
    int G, c;
    __device__ __forceinline__ bool next(int i, Unit& u) const {
        const int n = i % 3, j = i / 3, L = j * G + c;
        if (L >= 128 * 8) return false;
        { const int x = c & 7, w = c >> 3; u.pm = j * (G >> 3) + x * (G >> 6) + (w >> 3); u.pn = w & 7; }
        u.aux = n; u.kind = 0;
        const unsigned aoff = (n == 0) ? (unsigned)WS_YA : ((n == 1) ? (unsigned)WS_BG : (unsigned)WS_YC);
        u.a = aoff + (unsigned)u.pm * TSTEP1024;
        u.b = (unsigned)WS_WB + (unsigned)n * (2048u * 1024u * 2u) + (unsigned)u.pn * TSTEP1024;
        return true;
    }
};
struct SchedP3I {
    int G, c;
    __device__ __forceinline__ bool next(int i, Unit& u) const {
        const int n = i % 3, j = i / 3, L = j * G + c;
        if (L >= 128 * 8) return false;
        { const int x = c & 7, w = c >> 3; u.pm = j * (G >> 3) + x * (G >> 6) + (w >> 3); u.pn = w & 7; }
        u.aux = n; u.kind = i & 1;
        const unsigned aoff = (n == 0) ? (unsigned)WS_A80 : ((n == 1) ? (unsigned)WS_A81 : (unsigned)WS_A82);
        u.a = aoff + (unsigned)u.pm * (256u * 1024u);
        u.b = (unsigned)WS_WB + (unsigned)n * (2048u * 1024u) + (unsigned)u.pn * (256u * 1024u);
        return true;
    }
};
struct SchedP4I {
    int G, c; unsigned A8, B8;
    __device__ __forceinline__ bool next(int i, Unit& u) const {
        const int L = i * G + c;
        if (L >= 128 * 8) return false;
        pg8::tile_map(L, 128, 8, u.pm, u.pn);
        u.a = A8 + (unsigned)u.pm * TSTEP1024; u.b = B8 + (unsigned)u.pn * TSTEP1024; u.kind = 0; u.aux = i & 1;
        return true;
    }
};
struct SchedP5I {
    int G, c; unsigned A8, B8;
    __device__ __forceinline__ bool next(int i, Unit& u) const {
        const int L = i * G + c;
        if (L >= 128 * 8) return false;
        pg8::tile_map(L, 128, 8, u.pm, u.pn);
        u.a = A8 + (unsigned)u.pm * TSTEP1024; u.b = B8 + (unsigned)u.pn * TSTEP1024; u.kind = 0; u.aux = i & 1;
        return true;
    }
};
struct SchedSimple {
    int G, c, nM, nN; unsigned A, B;
    __device__ __forceinline__ bool next(int i, Unit& u) const {
        const int L = i * G + c;
        if (L >= nM * nN) return false;
        pg8::tile_map(L, nM, nN, u.pm, u.pn);
        u.a = A + (unsigned)u.pm * TSTEP2048; u.b = B + (unsigned)u.pn * TSTEP2048; u.kind = 0; u.aux = 0;
        return true;
    }
};

#define EPI_ROWS _Pragma("unroll") for (int ai = 0; ai < 2; ++ai) _Pragma("unroll") for (int m = 0; m < 4; ++m)
#define EPI_BJ _Pragma("unroll") for (int bj = 0; bj < 2; ++bj)
__device__ __forceinline__ u32x4 pack8(const f32x4 v0, const f32x4 v1) { u32x4 w; w.x = pk2(v0[0], v0[1]); w.y = pk2(v0[2], v0[3]); w.z = pk2(v1[0], v1[1]); w.w = pk2(v1[2], v1[3]); return w; }

__device__ __forceinline__ void st16wt(void* base, size_t byte_off, const u32x4 v) {
    const __amdgpu_buffer_rsrc_t r = __builtin_amdgcn_make_buffer_rsrc(base, 0, 0x7FFFFFFF, 0x00020000);
    __builtin_amdgcn_raw_buffer_store_b128(v, r, (int)byte_off, 0, 16);
}

struct EpiP1 {
    static constexpr bool CHAIN = false; static constexpr bool PRE = false;
    bf16_t *GA, *BG, *CH, *KF, *VF;
    __device__ __forceinline__ void operator()(const f32x4 (&acc)[2][2][4][2], const Unit& u, int wr, int wc, int fr, int fq) const {
        asm volatile("" : "+v"(fr), "+v"(fq));
        const int rt0 = 64 * wr + fr, ct0 = 32 * wc + 8 * fq;
        if (u.kind == 0) {
            EPI_ROWS { const int row = u.pm * 256 + 128 * ai + 16 * m + rt0; bf16_t* rp = GA + (size_t)row * 2048 + u.pn * 256 + ct0;
                EPI_BJ { f32x4 v0 = acc[ai][bj][m][0], v1 = acc[ai][bj][m][1];
#pragma unroll
                    for (int j = 0; j < 4; ++j) { v0[j] = gelu_tanh(v0[j]); v1[j] = gelu_tanh(v1[j]); }
                    *(u32x4*)(rp + bj * 128) = pack8(v0, v1); } }
        } else if (u.kind == 1) {
            EPI_ROWS { const int row = u.pm * 256 + 128 * ai + 16 * m + rt0; bf16_t* rp = BG + (size_t)row * 1024 + (u.pn - 8) * 256 + ct0;
                EPI_BJ { *(u32x4*)(rp + bj * 128) = pack8(acc[ai][bj][m][0], acc[ai][bj][m][1]); } }
        } else if (u.kind == 2) {
            EPI_ROWS { const int row = u.pm * 256 + 128 * ai + 16 * m + rt0; bf16_t* rp = CH + (size_t)row * 1024 + (u.pn - 12) * 128 + ct0;
                *(u32x4*)rp = pack8(acc[ai][0][m][0] * acc[ai][1][m][0], acc[ai][0][m][1] * acc[ai][1][m][1]); }
        } else if (u.kind == 5) {
            EPI_ROWS { const int key = 128 * ai + 16 * m + rt0;
                EPI_BJ { const int d = ct0 + 128 * bj;
                    const size_t o = ((((size_t)(u.pm * 4 + u.pn) * 8 + (key >> 5)) * 16 + (d >> 4)) * 64 + (key & 31) + 32 * ((d >> 3) & 1)) * 8;
                    *(u32x4*)(KF + o) = pack8(acc[ai][bj][m][0], acc[ai][bj][m][1]); } }
        } else {
            EPI_ROWS { const int d = 128 * ai + 16 * m + rt0;
                EPI_BJ { const int c = ct0 + 128 * bj; const int kstep = (c >> 4), jh = (c >> 3) & 1;
                    const size_t o = ((((size_t)(u.pn * 4 + u.pm) * 8 + (d >> 5)) * 16 + kstep) * 64 + (d & 31)) * 8 + 4 * jh;
                    const f32x4 v0 = acc[ai][bj][m][0], v1 = acc[ai][bj][m][1];
                    u32x2 w0, w1; w0.x = pk2(v0[0], v0[1]); w0.y = pk2(v0[2], v0[3]); w1.x = pk2(v1[0], v1[1]); w1.y = pk2(v1[2], v1[3]);
                    *(u32x2*)(VF + o) = w0; *(u32x2*)(VF + o + 32 * 8) = w1; } }
        }
    }
};
__device__ __forceinline__ f32x4 i2f4(const f32x4 a) { const i32x4 i = __builtin_bit_cast(i32x4, a); return (f32x4){(float)i[0], (float)i[1], (float)i[2], (float)i[3]}; }
struct EpiP1F {
    static constexpr bool CHAIN = false; static constexpr bool PRE = true;
    __device__ __forceinline__ void pre(LAS unsigned char* lds, const __amdgpu_buffer_rsrc_t rsrc, const Unit& u, int wid, int lane) const {
        const int so = wid < 4 ? (int)(WS_HS + (size_t)(u.pm * 256 + 64 * wid) * 4) : (int)(WS_CTL + CTL_CMX + (size_t)(u.pn * 256 + 64 * (wid - 4)) * 4);
        __builtin_amdgcn_raw_ptr_buffer_load_lds(rsrc, (LAS void*)(lds + LDSCTL_OFF + 4096 + u.aux * 2048 + wid * 256), 4, lane * 4, so, 0, 0);
    }
    bf16_t *GA, *BG, *CH, *Q; unsigned char* SG8; const float* HS; const unsigned* CMX; LAS const unsigned char* SIGT; LAS const unsigned short* GELT;
    __device__ __forceinline__ void operator()(const f32x4 (&acc)[2][2][4][2], const Unit& u, int wr, int wc, int fr, int fq) const {
        asm volatile("" : "+v"(fr), "+v"(fq));
        const int rt0 = 64 * wr + fr, ct0 = 32 * wc + 8 * fq;
        const LAS unsigned* sc = (const LAS unsigned*)(SIGT - 4096 + u.aux * 2048);
        f32x4 cs[2][2];
#pragma unroll
        for (int bj = 0; bj < 2; ++bj)
#pragma unroll
            for (int n = 0; n < 2; ++n) { const u32x4 cb = *(const LAS u32x4*)(sc + 256 + ct0 + 128 * bj + 4 * n);
#pragma unroll
                for (int j = 0; j < 4; ++j) cs[bj][n][j] = __uint_as_float(cb[j]) * (1.0f / 127.0f); }
        float sa8[2][4];
        EPI_ROWS { sa8[ai][m] = __uint_as_float(sc[128 * ai + 16 * m + rt0]); }
        if (u.kind == 0) {
            EPI_ROWS { const int row = u.pm * 256 + 128 * ai + 16 * m + rt0; const size_t ro = ((size_t)row * 2048 + u.pn * 256 + ct0) * 2;
                f32x2 sav = {sa8[ai][m], sa8[ai][m]}; asm volatile("" : "+v"(sav));
                EPI_BJ { f32x4 v[2];
#pragma unroll
                    for (int h = 0; h < 2; ++h) { const f32x4 a = i2f4(acc[ai][bj][m][h]);
#pragma unroll
                        for (int jp = 0; jp < 2; ++jp) {
                            const f32x2 x = (f32x2){a[2 * jp], a[2 * jp + 1]} * ((f32x2){cs[bj][h][2 * jp], cs[bj][h][2 * jp + 1]} * sav);
                            const f32x2 t = x * 512.0f + 4096.0f;
                            const unsigned i0 = (unsigned)__builtin_amdgcn_fmed3f(t.x, 0.0f, 8191.0f), i1 = (unsigned)__builtin_amdgcn_fmed3f(t.y, 0.0f, 8191.0f);
                            const f32x2 r = x * (f32x2){(float)__builtin_bit_cast(_Float16, GELT[i0]), (float)__builtin_bit_cast(_Float16, GELT[i1])};
                            v[h][2 * jp] = r.x; v[h][2 * jp + 1] = r.y; } }
                    st16wt(GA, ro + bj * 256, pack8(v[0], v[1])); } }
        } else if (u.kind == 1) {
            EPI_ROWS { const int row = u.pm * 256 + 128 * ai + 16 * m + rt0; const size_t ro = ((size_t)row * 1024 + (u.pn - 8) * 256 + ct0) * 2; const float sa = sa8[ai][m];
                EPI_BJ { st16wt(BG, ro + bj * 256, pack8(i2f4(acc[ai][bj][m][0]) * cs[bj][0] * sa, i2f4(acc[ai][bj][m][1]) * cs[bj][1] * sa)); } }
        } else if (u.kind == 2) {
            EPI_ROWS { const int row = u.pm * 256 + 128 * ai + 16 * m + rt0; const size_t ro = ((size_t)row * 1024 + (u.pn - 12) * 128 + ct0) * 2; const float sa = sa8[ai][m]; const float s2 = sa * sa;
                st16wt(CH, ro, pack8(i2f4(acc[ai][0][m][0]) * i2f4(acc[ai][1][m][0]) * cs[0][0] * cs[1][0] * s2, i2f4(acc[ai][0][m][1]) * i2f4(acc[ai][1][m][1]) * cs[0][1] * cs[1][1] * s2)); }
        } else if (u.kind == 3) {
            EPI_ROWS { const int row = u.pm * 256 + 128 * ai + 16 * m + rt0; const size_t ro = ((size_t)row * 1024 + (u.pn - 20) * 256 + ct0) * 2; const float sa = sa8[ai][m];
                EPI_BJ { st16wt(Q, ro + bj * 256, pack8(i2f4(acc[ai][bj][m][0]) * cs[bj][0] * sa, i2f4(acc[ai][bj][m][1]) * cs[bj][1] * sa)); } }
        } else {
            const int n = (u.pn - 24) >> 3, pnl = (u.pn - 24) & 7;
            const size_t to = ((size_t)(n * 128 + u.pm) * 8 + pnl) * 65536 + (size_t)(((wr * 4 + wc) * 8) * 64 + fr + 16 * fq) * 16;
            constexpr float TB = (float)(LDSCTL_OFF + 8192);
            unsigned q[2][8]; u32x4 w4;
#pragma unroll
            for (int g = 0; g <= 16; ++g) {
                if (g < 16) { const int ai = g >> 3, m = (g >> 1) & 3, bj = g & 1;
                    f32x2 sav = {sa8[ai][m] * 128.0f, sa8[ai][m] * 128.0f}; asm volatile("" : "+v"(sav));
#pragma unroll
                    for (int h = 0; h < 2; ++h) { const f32x4 a = i2f4(acc[ai][bj][m][h]);
#pragma unroll
                        for (int jp = 0; jp < 2; ++jp) {
                            const f32x2 t = (f32x2){a[2 * jp], a[2 * jp + 1]} * ((f32x2){cs[bj][h][2 * jp], cs[bj][h][2 * jp + 1]} * sav) + (2048.0f + TB);
                            const unsigned i0 = (unsigned)__builtin_amdgcn_fmed3f(t.x, TB, TB + 4095.0f), i1 = (unsigned)__builtin_amdgcn_fmed3f(t.y, TB, TB + 4095.0f);
                            q[g & 1][4 * h + 2 * jp] = *(LAS const unsigned char*)(size_t)i0; q[g & 1][4 * h + 2 * jp + 1] = *(LAS const unsigned char*)(size_t)i1; } } }
                __builtin_amdgcn_sched_barrier(0);
                if (g > 0) { const int gp = g - 1, ai = gp >> 3, m = (gp >> 1) & 3, bj = gp & 1;
                    w4[2 * bj] = __builtin_amdgcn_perm(__builtin_amdgcn_perm(q[gp & 1][3], q[gp & 1][2], 0x0c0c0400u), __builtin_amdgcn_perm(q[gp & 1][1], q[gp & 1][0], 0x0c0c0400u), 0x05040100u);
                    w4[2 * bj + 1] = __builtin_amdgcn_perm(__builtin_amdgcn_perm(q[gp & 1][7], q[gp & 1][6], 0x0c0c0400u), __builtin_amdgcn_perm(q[gp & 1][5], q[gp & 1][4], 0x0c0c0400u), 0x05040100u);
                    if (bj == 1) st16wt(SG8, to + (size_t)(ai * 4 + m) * 1024, w4); }
                __builtin_amdgcn_sched_barrier(0);
            }
        }
    }
};
struct EpiP3 {
    static constexpr bool CHAIN = true; static constexpr bool PRE = false;
    unsigned char* M8; const unsigned char* SG8; unsigned* RM; unsigned* CNT;
    __device__ __forceinline__ bool operator()(f32x4 (&acc)[2][2][4][2], const Unit& u, int wr, int wc, int fr, int fq) const {
        asm volatile("" : "+v"(fr), "+v"(fq));
        const int rt0 = 64 * wr + fr, ct0 = 32 * wc + 8 * fq; const int n = u.aux;
        const __amdgpu_buffer_rsrc_t rs_ = __builtin_amdgcn_make_buffer_rsrc((void*)SG8, 0, 0x7FFFFFFF, 0x00020000);
        const int vo = (((wr * 4 + wc) * 8) * 64 + fr + 16 * fq) * 16;
        const int nn = n < 2 ? n : 2;
        const int so = ((nn * 128 + u.pm) * 8 + u.pn) * 65536;
        const int so2 = n < 2 ? so + 128 * 8 * 65536 : so;
        const unsigned keep = n < 2 ? 0xFFFFFFFFu : 0u; const float cb = n < 2 ? 0.5f : 256.0f;
        u32x2 ga[2][4][2], gb[2][4][2];
        EPI_ROWS { const u32x4 a4 = __builtin_bit_cast(u32x4, __builtin_amdgcn_raw_buffer_load_b128(rs_, vo, so + (ai * 4 + m) * 1024, 0)), b4 = __builtin_bit_cast(u32x4, __builtin_amdgcn_raw_buffer_load_b128(rs_, vo, so2 + (ai * 4 + m) * 1024, 0));
            ga[ai][m][0] = (u32x2){a4.x, a4.y}; ga[ai][m][1] = (u32x2){a4.z, a4.w}; gb[ai][m][0] = (u32x2){b4.x & keep, b4.y & keep}; gb[ai][m][1] = (u32x2){b4.z & keep, b4.w & keep}; }
        EPI_ROWS {
            EPI_BJ {
                float r_[8];
#pragma unroll
                for (int j = 0; j < 4; ++j) {
                    const f32x2 av = (f32x2){(float)((ga[ai][m][bj].x >> (8 * j)) & 255u), (float)((ga[ai][m][bj].y >> (8 * j)) & 255u)} + 0.5f;
                    const f32x2 bv = (f32x2){(float)((gb[ai][m][bj].x >> (8 * j)) & 255u), (float)((gb[ai][m][bj].y >> (8 * j)) & 255u)} + cb;
                    const f32x2 rv = av * (f32x2){__builtin_amdgcn_rcpf(bv.x), __builtin_amdgcn_rcpf(bv.y)};
                    r_[j] = rv.x; r_[4 + j] = rv.y; }
#pragma unroll
                for (int j = 0; j < 4; ++j) { asm volatile("v_mul_f32 %0, %0, %1" : "+v"(acc[ai][bj][m][0][j]) : "v"(r_[j])); asm volatile("v_mul_f32 %0, %0, %1" : "+v"(acc[ai][bj][m][1][j]) : "v"(r_[4 + j])); }
            } }
        if (n == 2) {
            unsigned* rmp = RM + u.pm * 256;
            EPI_ROWS { float v = 0.f;
                EPI_BJ {
#pragma unroll
                    for (int j = 0; j < 4; ++j) v = fmaxf(v, fmaxf(fabsf(acc[ai][bj][m][0][j]), fabsf(acc[ai][bj][m][1][j]))); }
                v = fmaxf(v, __shfl_xor(v, 16)); v = fmaxf(v, __shfl_xor(v, 32));
                if (fq == 0) atomicMax(rmp + 128 * ai + 16 * m + rt0, __float_as_uint(v)); }
            asm volatile("s_waitcnt vmcnt(0)" ::: "memory");
            __builtin_amdgcn_s_barrier();
            if (threadIdx.x == 0) {
                (void)__hip_atomic_fetch_add(CNT + u.pm, 1u, __ATOMIC_RELAXED, __HIP_MEMORY_SCOPE_AGENT);
                unsigned sp = 0u;
                while (__hip_atomic_load(CNT + u.pm, __ATOMIC_RELAXED, __HIP_MEMORY_SCOPE_AGENT) < 8u && ++sp < (1u << 22)) __builtin_amdgcn_s_sleep(1);
            }
            __builtin_amdgcn_s_barrier();
            EPI_ROWS { const int row = u.pm * 256 + 128 * ai + 16 * m + rt0;
                const float rmax = __uint_as_float(__hip_atomic_load(rmp + 128 * ai + 16 * m + rt0, __ATOMIC_RELAXED, __HIP_MEMORY_SCOPE_AGENT)); const float inv = rmax > 0.f ? 127.0f / rmax : 0.f;
                EPI_BJ { u32x2 o;
#pragma unroll
                    for (int h = 0; h < 2; ++h) { const int a = (int)rintf(acc[ai][bj][m][h][0] * inv), b = (int)rintf(acc[ai][bj][m][h][1] * inv), c = (int)rintf(acc[ai][bj][m][h][2] * inv), d = (int)rintf(acc[ai][bj][m][h][3] * inv);
                        o[h] = (unsigned)(a & 255) | ((unsigned)(b & 255) << 8) | ((unsigned)(c & 255) << 16) | ((unsigned)(d & 255) << 24); }
                    *(u32x2*)(M8 + (size_t)row * 2048 + u.pn * 256 + ct0 + 128 * bj) = o;
#pragma unroll
                    for (int j = 0; j < 4; ++j) { asm volatile("v_mul_f32 %0, 0, %0" : "+v"(acc[ai][bj][m][0][j])); asm volatile("v_mul_f32 %0, 0, %0" : "+v"(acc[ai][bj][m][1][j])); } } }
        }
        return true;
    }
};
struct EpiP3I {
    static constexpr bool CHAIN = true; static constexpr bool PRE = true;
    __device__ __forceinline__ void pre(LAS unsigned char* lds, const __amdgpu_buffer_rsrc_t rsrc, const Unit& u, int wid, int lane) const {
        const int q = wid & 3, hi = wid >> 2, nn = (hi && u.aux < 2) ? u.aux + 1 : u.aux;
        LAS unsigned char* base = lds + LDSCTL_OFF + 8192 + u.kind * 4096 + hi * 1024 + q * 256;
        __builtin_amdgcn_raw_ptr_buffer_load_lds(rsrc, (LAS void*)base, 4, lane * 4, (int)(WS_RA + ((size_t)nn * M + u.pm * 256 + 64 * q) * 4), 0, 0);
        __builtin_amdgcn_raw_ptr_buffer_load_lds(rsrc, (LAS void*)(base + 2048), 4, lane * 4, (int)(WS_CTL + CTL_CMXB + ((size_t)nn * 2048 + u.pn * 256 + 64 * q) * 4), 0, 0);
    }
    unsigned char* M8; const unsigned char* SG8; unsigned* RM; unsigned* CNT; LAS const unsigned char* SC;
    __device__ __forceinline__ bool operator()(f32x4 (&acc)[2][2][4][2], const Unit& u, int wr, int wc, int fr, int fq) const {
        asm volatile("" : "+v"(fr), "+v"(fq));
        const int rt0 = 64 * wr + fr, ct0 = 32 * wc + 8 * fq; const int n = u.aux;
        const __amdgpu_buffer_rsrc_t rs_ = __builtin_amdgcn_make_buffer_rsrc((void*)SG8, 0, 0x7FFFFFFF, 0x00020000);
        const int vo = (((wr * 4 + wc) * 8) * 64 + fr + 16 * fq) * 16;
        const int nn = n < 2 ? n : 2;
        const int so = ((nn * 128 + u.pm) * 8 + u.pn) * 65536;
        const int so2 = n < 2 ? so + 128 * 8 * 65536 : so;
        const unsigned keep = n < 2 ? 0xFFFFFFFFu : 0u; const float cb = n < 2 ? 0.5f : 256.0f;
        u32x2 ga[2][4][2], gb[2][4][2];
        EPI_ROWS { const u32x4 a4 = __builtin_bit_cast(u32x4, __builtin_amdgcn_raw_buffer_load_b128(rs_, vo, so + (ai * 4 + m) * 1024, 0)), b4 = __builtin_bit_cast(u32x4, __builtin_amdgcn_raw_buffer_load_b128(rs_, vo, so2 + (ai * 4 + m) * 1024, 0));
            ga[ai][m][0] = (u32x2){a4.x, a4.y}; ga[ai][m][1] = (u32x2){a4.z, a4.w}; gb[ai][m][0] = (u32x2){b4.x & keep, b4.y & keep}; gb[ai][m][1] = (u32x2){b4.z & keep, b4.w & keep}; }
        const LAS unsigned* sc = (const LAS unsigned*)(SC + u.kind * 4096);
        float Rr[2][4]; f32x4 Cc[2][2];
        EPI_ROWS { const float ra = __uint_as_float(sc[128 * ai + 16 * m + rt0]), rb = __uint_as_float(sc[256 + 128 * ai + 16 * m + rt0]); Rr[ai][m] = n < 2 ? ra * __builtin_amdgcn_rcpf(rb) : ra; }
#pragma unroll
        for (int bj = 0; bj < 2; ++bj)
#pragma unroll
            for (int h = 0; h < 2; ++h) { const u32x4 ca = *(const LAS u32x4*)(sc + 512 + ct0 + 128 * bj + 4 * h), cb2 = *(const LAS u32x4*)(sc + 768 + ct0 + 128 * bj + 4 * h);
#pragma unroll
                for (int j = 0; j < 4; ++j) { const float fa = __uint_as_float(ca[j]), fb = __uint_as_float(cb2[j]); const float ga_ = fa > 0.f ? fa : 127.0f, gb_ = fb > 0.f ? fb : 127.0f;
                    Cc[bj][h][j] = n < 2 ? ga_ * __builtin_amdgcn_rcpf(gb_) : ga_ * (1.0f / 127.0f); } }
        EPI_ROWS {
            EPI_BJ {
                float r_[8];
#pragma unroll
                for (int j = 0; j < 4; ++j) {
                    const f32x2 av = (f32x2){(float)((ga[ai][m][bj].x >> (8 * j)) & 255u), (float)((ga[ai][m][bj].y >> (8 * j)) & 255u)} + 0.5f;
                    const f32x2 bv = (f32x2){(float)((gb[ai][m][bj].x >> (8 * j)) & 255u), (float)((gb[ai][m][bj].y >> (8 * j)) & 255u)} + cb;
                    const f32x2 rv = av * (f32x2){__builtin_amdgcn_rcpf(bv.x), __builtin_amdgcn_rcpf(bv.y)};
                    r_[j] = rv.x * (Rr[ai][m] * Cc[bj][0][j]); r_[4 + j] = rv.y * (Rr[ai][m] * Cc[bj][1][j]); }
#pragma unroll
                for (int j = 0; j < 4; ++j) { asm volatile("v_cvt_f32_i32 %0, %0\n\tv_mul_f32 %0, %0, %1" : "+v"(acc[ai][bj][m][0][j]) : "v"(r_[j])); asm volatile("v_cvt_f32_i32 %0, %0\n\tv_mul_f32 %0, %0, %1" : "+v"(acc[ai][bj][m][1][j]) : "v"(r_[4 + j])); }
            } }
        if (n < 2) {
            EPI_ROWS { EPI_BJ {
#pragma unroll
                for (int j = 0; j < 4; ++j) { asm volatile("v_rndne_f32 %0, %0\n\tv_cvt_i32_f32 %0, %0" : "+v"(acc[ai][bj][m][0][j])); asm volatile("v_rndne_f32 %0, %0\n\tv_cvt_i32_f32 %0, %0" : "+v"(acc[ai][bj][m][1][j])); } } }
        }
        if (n == 2) {
            unsigned* rmp = RM + u.pm * 256;
            EPI_ROWS { float v = 0.f;
                EPI_BJ {
#pragma unroll
                    for (int j = 0; j < 4; ++j) v = fmaxf(v, fmaxf(fabsf(acc[ai][bj][m][0][j]), fabsf(acc[ai][bj][m][1][j]))); }
                v = fmaxf(v, __shfl_xor(v, 16)); v = fmaxf(v, __shfl_xor(v, 32));
                if (fq == 0) atomicMax(rmp + 128 * ai + 16 * m + rt0, __float_as_uint(v)); }
            asm volatile("s_waitcnt vmcnt(0)" ::: "memory");
            __builtin_amdgcn_s_barrier();
            if (threadIdx.x == 0) {
                (void)__hip_atomic_fetch_add(CNT + u.pm, 1u, __ATOMIC_RELAXED, __HIP_MEMORY_SCOPE_AGENT);
                unsigned sp = 0u;
                while (__hip_atomic_load(CNT + u.pm, __ATOMIC_RELAXED, __HIP_MEMORY_SCOPE_AGENT) < 8u && ++sp < (1u << 22)) __builtin_amdgcn_s_sleep(1);
            }
            __builtin_amdgcn_s_barrier();
            EPI_ROWS { const int row = u.pm * 256 + 128 * ai + 16 * m + rt0;
                const float rmax = __uint_as_float(__hip_atomic_load(rmp + 128 * ai + 16 * m + rt0, __ATOMIC_RELAXED, __HIP_MEMORY_SCOPE_AGENT)); const float inv = rmax > 0.f ? 127.0f / rmax : 0.f;
                EPI_BJ { u32x2 o;
#pragma unroll
                    for (int h = 0; h < 2; ++h) { const int a = (int)rintf(acc[ai][bj][m][h][0] * inv), b = (int)rintf(acc[ai][bj][m][h][1] * inv), c = (int)rintf(acc[ai][bj][m][h][2] * inv), d = (int)rintf(acc[ai][bj][m][h][3] * inv);
                        o[h] = (unsigned)(a & 255) | ((unsigned)(b & 255) << 8) | ((unsigned)(c & 255) << 16) | ((unsigned)(d & 255) << 24); }
                    *(u32x2*)(M8 + (size_t)row * 2048 + u.pn * 256 + ct0 + 128 * bj) = o;
#pragma unroll
                    for (int j = 0; j < 4; ++j) { asm volatile("v_mov_b32 %0, 0" : "+v"(acc[ai][bj][m][0][j])); asm volatile("v_mov_b32 %0, 0" : "+v"(acc[ai][bj][m][1][j])); } } }
        }
        return true;
    }
};
struct EpiP4 {
    static constexpr bool CHAIN = false; static constexpr bool PRE = false;
    const float* X; float* OUT; bf16_t* X2B; float* SSP;
    __device__ __forceinline__ void operator()(const f32x4 (&acc)[2][2][4][2], const Unit& u, int wr, int wc, int fr, int fq) const {
        asm volatile("" : "+v"(fr), "+v"(fq));
        const int rt0 = 64 * wr + fr, ct0 = 32 * wc + 8 * fq;
        f32x4 xr[2][2][2][2];
#pragma unroll
        for (int b = 0; b <= 4; ++b) {
            if (b < 4) { const int ai = b >> 1;
#pragma unroll
                for (int mm = 0; mm < 2; ++mm) { const int m = (b & 1) * 2 + mm, row = u.pm * 256 + 128 * ai + 16 * m + rt0;
                    EPI_BJ { const size_t o = (size_t)row * 2048 + u.pn * 256 + ct0 + 128 * bj; xr[b & 1][mm][bj][0] = *(const f32x4*)(X + o); xr[b & 1][mm][bj][1] = *(const f32x4*)(X + o + 4); } } }
            __builtin_amdgcn_sched_barrier(0);
            if (b > 0) { const int c = b - 1, ai = c >> 1;
#pragma unroll
                for (int mm = 0; mm < 2; ++mm) { const int m = (c & 1) * 2 + mm, row = u.pm * 256 + 128 * ai + 16 * m + rt0; float ss = 0.f;
                    EPI_BJ { const size_t o = (size_t)row * 2048 + u.pn * 256 + ct0 + 128 * bj;
                        const f32x4 v0 = acc[ai][bj][m][0] + xr[c & 1][mm][bj][0], v1 = acc[ai][bj][m][1] + xr[c & 1][mm][bj][1];
                        st16wt(X2B, o * 2, pack8(v0, v1));
                        ss += (v0[0] * v0[0] + v0[1] * v0[1]) + (v0[2] * v0[2] + v0[3] * v0[3]) + (v1[0] * v1[0] + v1[1] * v1[1]) + (v1[2] * v1[2] + v1[3] * v1[3]); }
                    ss += __shfl_xor(ss, 16); ss += __shfl_xor(ss, 32);
                    SSP[(size_t)row * 32 + u.pn * 4 + wc] = ss; } }
            __builtin_amdgcn_sched_barrier(0);
        }
    }
};
struct EpiP4I {
    static constexpr bool CHAIN = false; static constexpr bool PRE = true;
    __device__ __forceinline__ void pre(LAS unsigned char* lds, const __amdgpu_buffer_rsrc_t rsrc, const Unit& u, int wid, int lane) const {
        const int so = wid < 4 ? (int)(WS_CTL + CTL_RM + (size_t)(u.pm * 256 + 64 * wid) * 4) : (int)(WS_CTL + CTL_CMXO + (size_t)(u.pn * 256 + 64 * (wid - 4)) * 4);
        __builtin_amdgcn_raw_ptr_buffer_load_lds(rsrc, (LAS void*)(lds + LDSCTL_OFF + 4096 + u.aux * 2048 + wid * 256), 4, lane * 4, so, 0, 0);
    }
    const float* X; bf16_t* X2B; float* SSP; LAS const unsigned char* SC;
    __device__ __forceinline__ void operator()(const f32x4 (&acc)[2][2][4][2], const Unit& u, int wr, int wc, int fr, int fq) const {
        asm volatile("" : "+v"(fr), "+v"(fq));
        const int rt0 = 64 * wr + fr, ct0 = 32 * wc + 8 * fq;
        const LAS unsigned* sc = (const LAS unsigned*)(SC + u.aux * 2048);
        f32x4 cs[2][2];
#pragma unroll
        for (int bj = 0; bj < 2; ++bj)
#pragma unroll
            for (int n = 0; n < 2; ++n) { const u32x4 cb = *(const LAS u32x4*)(sc + 256 + ct0 + 128 * bj + 4 * n);
#pragma unroll
                for (int j = 0; j < 4; ++j) cs[bj][n][j] = __uint_as_float(cb[j]) * (1.0f / 127.0f); }
        float sa8[2][4];
        EPI_ROWS { sa8[ai][m] = __uint_as_float(sc[128 * ai + 16 * m + rt0]) * (1.0f / 127.0f); }
        f32x4 xr[2][2][2][2];
#pragma unroll
        for (int b = 0; b <= 4; ++b) {
            if (b < 4) { const int ai = b >> 1;
#pragma unroll
                for (int mm = 0; mm < 2; ++mm) { const int m = (b & 1) * 2 + mm, row = u.pm * 256 + 128 * ai + 16 * m + rt0;
                    EPI_BJ { const size_t o = (size_t)row * 2048 + u.pn * 256 + ct0 + 128 * bj; xr[b & 1][mm][bj][0] = *(const f32x4*)(X + o); xr[b & 1][mm][bj][1] = *(const f32x4*)(X + o + 4); } } }
            __builtin_amdgcn_sched_barrier(0);
            if (b > 0) { const int c = b - 1, ai = c >> 1;
#pragma unroll
                for (int mm = 0; mm < 2; ++mm) { const int m = (c & 1) * 2 + mm, row = u.pm * 256 + 128 * ai + 16 * m + rt0; float ss = 0.f; const float sa = sa8[ai][m];
                    EPI_BJ { const size_t o = (size_t)row * 2048 + u.pn * 256 + ct0 + 128 * bj;
                        const f32x4 v0 = i2f4(acc[ai][bj][m][0]) * (cs[bj][0] * sa) + xr[c & 1][mm][bj][0], v1 = i2f4(acc[ai][bj][m][1]) * (cs[bj][1] * sa) + xr[c & 1][mm][bj][1];
                        st16wt(X2B, o * 2, pack8(v0, v1));
                        ss += (v0[0] * v0[0] + v0[1] * v0[1]) + (v0[2] * v0[2] + v0[3] * v0[3]) + (v1[0] * v1[0] + v1[1] * v1[1]) + (v1[2] * v1[2] + v1[3] * v1[3]); }
                    ss += __shfl_xor(ss, 16); ss += __shfl_xor(ss, 32);
                    SSP[(size_t)row * 32 + u.pn * 4 + wc] = ss; } }
            __builtin_amdgcn_sched_barrier(0);
        }
    }
};
struct EpiP5I {
    static constexpr bool CHAIN = false; static constexpr bool PRE = true;
    __device__ __forceinline__ void pre(LAS unsigned char* lds, const __amdgpu_buffer_rsrc_t rsrc, const Unit& u, int wid, int lane) const {
        const int so = wid < 4 ? (int)(WS_HS + (size_t)(u.pm * 256 + 64 * wid) * 4) : (int)(WS_CTL + CTL_CMXQ + (size_t)(u.pn * 256 + 64 * (wid - 4)) * 4);
        __builtin_amdgcn_raw_ptr_buffer_load_lds(rsrc, (LAS void*)(lds + LDSCTL_OFF + 4096 + u.aux * 2048 + wid * 256), 4, lane * 4, so, 0, 0);
    }
    bf16_t* O; LAS const unsigned char* SC;
    __device__ __forceinline__ void operator()(const f32x4 (&acc)[2][2][4][2], const Unit& u, int wr, int wc, int fr, int fq) const {
        asm volatile("" : "+v"(fr), "+v"(fq));
        const int rt0 = 64 * wr + fr, ct0 = 32 * wc + 8 * fq;
        const LAS unsigned* sc = (const LAS unsigned*)(SC + u.aux * 2048);
        f32x4 cs[2][2];
#pragma unroll
        for (int bj = 0; bj < 2; ++bj)
#pragma unroll
            for (int n = 0; n < 2; ++n) { const u32x4 cb = *(const LAS u32x4*)(sc + 256 + ct0 + 128 * bj + 4 * n);
#pragma unroll
                for (int j = 0; j < 4; ++j) cs[bj][n][j] = __uint_as_float(cb[j]) * (1.0f / 127.0f); }
        EPI_ROWS { const int row = u.pm * 256 + 128 * ai + 16 * m + rt0; const size_t ro = ((size_t)row * 2048 + u.pn * 256 + ct0) * 2; const float sa = __uint_as_float(sc[128 * ai + 16 * m + rt0]);
            EPI_BJ { st16wt(O, ro + bj * 256, pack8(i2f4(acc[ai][bj][m][0]) * cs[bj][0] * sa, i2f4(acc[ai][bj][m][1]) * cs[bj][1] * sa)); } }
    }
};
struct EpiBf {
    static constexpr bool CHAIN = false; static constexpr bool PRE = false;
    bf16_t* O;
    __device__ __forceinline__ void operator()(const f32x4 (&acc)[2][2][4][2], const Unit& u, int wr, int wc, int fr, int fq) const {
        asm volatile("" : "+v"(fr), "+v"(fq));
        const int rt0 = 64 * wr + fr, ct0 = 32 * wc + 8 * fq;
        EPI_ROWS { const int row = u.pm * 256 + 128 * ai + 16 * m + rt0; const size_t ro = ((size_t)row * 2048 + u.pn * 256 + ct0) * 2;
            EPI_BJ { st16wt(O, ro + bj * 256, pack8(acc[ai][bj][m][0], acc[ai][bj][m][1])); } }
    }
};

__device__ __forceinline__ void p0_transpose_item(const float* W, int ldw, int scol0, int k0, bf16_t* WT, int drow0, int K, const float* kscale, LAS float* scr, int lane) {
    {
        const int rr = lane >> 3, cq = (lane & 7) * 4; f32x4 v[8];
#pragma unroll
        for (int i = 0; i < 8; ++i) v[i] = *(const f32x4*)(W + (size_t)(k0 + 8 * i + rr) * ldw + scol0 + cq);
#pragma unroll
        for (int i = 0; i < 8; ++i) { const int kk = 8 * i + rr; const float ks = kscale ? kscale[k0 + kk] : 1.0f;
            scr[kk * 33 + cq] = v[i].x * ks; scr[kk * 33 + cq + 1] = v[i].y * ks; scr[kk * 33 + cq + 2] = v[i].z * ks; scr[kk * 33 + cq + 3] = v[i].w * ks; }
    }
    asm volatile("s_waitcnt lgkmcnt(0)" ::: "memory");
    const int c = lane & 7;
#pragma unroll
    for (int j = 0; j < 4; ++j) { const int n = (lane >> 3) + 8 * j; const LAS float* s = scr + (8 * c) * 33 + n;
        u32x4 o; o.x = pk2(s[0 * 33], s[1 * 33]); o.y = pk2(s[2 * 33], s[3 * 33]); o.z = pk2(s[4 * 33], s[5 * 33]); o.w = pk2(s[6 * 33], s[7 * 33]);
        *(u32x4*)(WT + (size_t)(drow0 + n) * K + k0 + 8 * c) = o; }
    asm volatile("s_waitcnt lgkmcnt(0)" ::: "memory");
}
__device__ __forceinline__ int win_src_col(int j) {
    if (j < 3072 || j >= 5120) return j;
    const int lj = j - 3072, q = lj >> 8, lc = lj & 255, ch = q * 128 + (lc & 127);
    return (lc < 128) ? 3072 + ch : 4096 + ch;
}
__device__ __forceinline__ void row_to_bf16(const float* xrow, bf16_t* orow, const float* g, int lane) {
    const f32x4* xr = (const f32x4*)xrow + lane;
    f32x4 v[8]; float s = 0.f;
#pragma unroll
    for (int j = 0; j < 8; ++j) { v[j] = xr[64 * j]; s += (v[j].x * v[j].x + v[j].y * v[j].y) + (v[j].z * v[j].z + v[j].w * v[j].w); }
    float rs = 1.0f;
    if (g) { rs = __builtin_amdgcn_rsqf(wave_sum(s) * (1.0f / 2048.0f) + EPS); }
    u32x2* o8 = (u32x2*)orow + lane;
#pragma unroll
    for (int j = 0; j < 8; ++j) { f32x4 gg = {1.f, 1.f, 1.f, 1.f}; if (g) gg = ((const f32x4*)g)[64 * j + lane];
        u32x2 w; w.x = pk2(v[j].x * rs * gg.x, v[j].y * rs * gg.y); w.y = pk2(v[j].z * rs * gg.z, v[j].w * rs * gg.w); o8[64 * j] = w; }
}

__device__ __forceinline__ void row_to_fp4u(const float* xrow, unsigned char* wu4, float* scale, int e, int lane) {
    const f32x4* xr = (const f32x4*)xrow + lane;
    f32x4 v[8]; float mx = 0.f;
#pragma unroll
    for (int j = 0; j < 8; ++j) { v[j] = xr[64 * j]; mx = fmaxf(mx, fmaxf(fmaxf(fabsf(v[j].x), fabsf(v[j].y)), fmaxf(fabsf(v[j].z), fabsf(v[j].w)))); }
#pragma unroll
    for (int o = 1; o < 64; o <<= 1) mx = fmaxf(mx, __shfl_xor(mx, o));
    const unsigned scb = pk2(mx * (1.0f / 6.0f), 0.f) & 0xffffu;
    const float scr_ = __uint_as_float(scb << 16);
    const float inv = scr_ > 0.f ? 1.0f / scr_ : 0.f;
    if (lane == 0) *scale = scr_;
#pragma unroll
    for (int j = 0; j < 8; ++j) { unsigned h = 0u;
#pragma unroll
        for (int x = 0; x < 4; ++x) { const float f = v[j][x]; const float a = fabsf(f) * inv;
            const unsigned c = (unsigned)(a > 0.25f) + (unsigned)(a > 0.75f) + (unsigned)(a > 1.25f) + (unsigned)(a > 1.75f) + (unsigned)(a > 2.5f) + (unsigned)(a > 3.5f) + (unsigned)(a > 5.0f);
            h |= (c | ((__float_as_uint(f) >> 28) & 8u)) << (4 * x); }
        *(unsigned short*)(wu4 + ((size_t)j * 16384 + e) * 128 + 2 * lane) = (unsigned short)h; }
}
__device__ __forceinline__ void row_h1(const float* xrow, unsigned char* o8row, float* scale, const float* g, int lane) {
    const f32x4* xr = (const f32x4*)xrow + lane;
    f32x4 v[8]; float s = 0.f;
#pragma unroll
    for (int j = 0; j < 8; ++j) { v[j] = xr[64 * j]; s += (v[j].x * v[j].x + v[j].y * v[j].y) + (v[j].z * v[j].z + v[j].w * v[j].w); }
    const float rs = __builtin_amdgcn_rsqf(wave_sum(s) * (1.0f / 2048.0f) + EPS);
    float mx = 0.f;
#pragma unroll
    for (int j = 0; j < 8; ++j) { const f32x4 gg = ((const f32x4*)g)[64 * j + lane]; v[j] = v[j] * rs * gg; mx = fmaxf(mx, fmaxf(fmaxf(fabsf(v[j].x), fabsf(v[j].y)), fmaxf(fabsf(v[j].z), fabsf(v[j].w)))); }
#pragma unroll
    for (int o = 1; o < 64; o <<= 1) mx = fmaxf(mx, __shfl_xor(mx, o));
    const float inv = mx > 0.f ? 127.0f / mx : 0.f;
    if (lane == 0) *scale = mx * (1.0f / 127.0f);
    unsigned* o4 = (unsigned*)o8row + lane;
#pragma unroll
    for (int j = 0; j < 8; ++j) { const int a = (int)rintf(v[j].x * inv), b = (int)rintf(v[j].y * inv), c = (int)rintf(v[j].z * inv), d = (int)rintf(v[j].w * inv);
        o4[64 * j] = (unsigned)(a & 255) | ((unsigned)(b & 255) << 8) | ((unsigned)(c & 255) << 16) | ((unsigned)(d & 255) << 24); }
}
__device__ __forceinline__ void row_q8(const bf16_t* xrow, unsigned char* o8row, float* scale, int lane) {
    u32x4 w[4]; float mx = 0.f;
#pragma unroll
    for (int j = 0; j < 4; ++j) { w[j] = *(const u32x4*)(xrow + 512 * j + 8 * lane);
#pragma unroll
        for (int x = 0; x < 4; ++x) mx = fmaxf(mx, fmaxf(fabsf(bf_lo(w[j][x])), fabsf(bf_hi(w[j][x])))); }
#pragma unroll
    for (int o = 1; o < 64; o <<= 1) mx = fmaxf(mx, __shfl_xor(mx, o));
    const float inv = mx > 0.f ? 127.0f / mx : 0.f;
    if (lane == 0) *scale = mx * (1.0f / 127.0f);
#pragma unroll
    for (int j = 0; j < 4; ++j) { u32x2 o;
#pragma unroll
        for (int h = 0; h < 2; ++h) { const int a = (int)rintf(bf_lo(w[j][2 * h]) * inv), b = (int)rintf(bf_hi(w[j][2 * h]) * inv), c = (int)rintf(bf_lo(w[j][2 * h + 1]) * inv), d = (int)rintf(bf_hi(w[j][2 * h + 1]) * inv);
            o[h] = (unsigned)(a & 255) | ((unsigned)(b & 255) << 8) | ((unsigned)(c & 255) << 16) | ((unsigned)(d & 255) << 24); }
        *(u32x2*)(o8row + 512 * j + 8 * lane) = o; }
}
__device__ __forceinline__ void row_q8h(const bf16_t* xrow, unsigned char* o8row, float* scale, int lane) {
    u32x4 w[2]; float mx = 0.f;
#pragma unroll
    for (int j = 0; j < 2; ++j) { w[j] = *(const u32x4*)(xrow + 512 * j + 8 * lane);
#pragma unroll
        for (int x = 0; x < 4; ++x) mx = fmaxf(mx, fmaxf(fabsf(bf_lo(w[j][x])), fabsf(bf_hi(w[j][x])))); }
#pragma unroll
    for (int o = 1; o < 64; o <<= 1) mx = fmaxf(mx, __shfl_xor(mx, o));
    const float inv = mx > 0.f ? 127.0f / mx : 0.f;
    if (lane == 0) *scale = mx > 0.f ? mx * (1.0f / 127.0f) : 1.0f;
#pragma unroll
    for (int j = 0; j < 2; ++j) { u32x2 o;
#pragma unroll
        for (int h = 0; h < 2; ++h) { const int a = (int)rintf(bf_lo(w[j][2 * h]) * inv), b = (int)rintf(bf_hi(w[j][2 * h]) * inv), c = (int)rintf(bf_lo(w[j][2 * h + 1]) * inv), d = (int)rintf(bf_hi(w[j][2 * h + 1]) * inv);
            o[h] = (unsigned)(a & 255) | ((unsigned)(b & 255) << 8) | ((unsigned)(c & 255) << 16) | ((unsigned)(d & 255) << 24); }
        *(u32x2*)(o8row + 512 * j + 8 * lane) = o; }
}
template <int NJ, int NR>
__device__ __forceinline__ void rows_q8(const bf16_t* X, unsigned char* O, float* S, int r0, int rstep, int rlast, float zs, int lane) {
    u32x4 w[NR][NJ]; float mx[NR]; int rr[NR];
#pragma unroll
    for (int q = 0; q < NR; ++q) { rr[q] = r0 + q * rstep; rr[q] = rr[q] <= rlast ? rr[q] : r0; mx[q] = 0.f;
#pragma unroll
        for (int j = 0; j < NJ; ++j) w[q][j] = *(const u32x4*)(X + (size_t)rr[q] * (NJ * 512) + 512 * j + 8 * lane); }
#pragma unroll
    for (int q = 0; q < NR; ++q)
#pragma unroll
        for (int j = 0; j < NJ; ++j)
#pragma unroll
            for (int x = 0; x < 4; ++x) mx[q] = fmaxf(mx[q], fmaxf(fabsf(bf_lo(w[q][j][x])), fabsf(bf_hi(w[q][j][x]))));
#pragma unroll
    for (int o = 1; o < 64; o <<= 1)
#pragma unroll
        for (int q = 0; q < NR; ++q) mx[q] = fmaxf(mx[q], __shfl_xor(mx[q], o));
#pragma unroll
    for (int q = 0; q < NR; ++q) { const float inv = mx[q] > 0.f ? 127.0f / mx[q] : 0.f; unsigned char* orow = O + (size_t)rr[q] * (NJ * 512);
        if (lane == 0) S[rr[q]] = mx[q] > 0.f ? mx[q] * (1.0f / 127.0f) : zs;
#pragma unroll
        for (int j = 0; j < NJ; ++j) { u32x2 o;
#pragma unroll
            for (int h = 0; h < 2; ++h) { const int a = (int)rintf(bf_lo(w[q][j][2 * h]) * inv), b = (int)rintf(bf_hi(w[q][j][2 * h]) * inv), c = (int)rintf(bf_lo(w[q][j][2 * h + 1]) * inv), d = (int)rintf(bf_hi(w[q][j][2 * h + 1]) * inv);
                o[h] = (unsigned)(a & 255) | ((unsigned)(b & 255) << 8) | ((unsigned)(c & 255) << 16) | ((unsigned)(d & 255) << 24); }
            *(u32x2*)(orow + 512 * j + 8 * lane) = o; } }
}
__device__ __forceinline__ void p0_colmax_item(const float* W, int ldw, int col0, int k0, unsigned* cmx, int lane, const float* kscale = nullptr) {
    const int rr = lane >> 3, cq = (lane & 7) * 4; f32x4 v[8];
#pragma unroll
    for (int i = 0; i < 8; ++i) { v[i] = *(const f32x4*)(W + (size_t)(k0 + 8 * i + rr) * ldw + col0 + cq); if (kscale) v[i] = v[i] * kscale[k0 + 8 * i + rr]; }
    f32x4 mx = {0.f, 0.f, 0.f, 0.f};
#pragma unroll
    for (int i = 0; i < 8; ++i) { mx.x = fmaxf(mx.x, fabsf(v[i].x)); mx.y = fmaxf(mx.y, fabsf(v[i].y)); mx.z = fmaxf(mx.z, fabsf(v[i].z)); mx.w = fmaxf(mx.w, fabsf(v[i].w)); }
#pragma unroll
    for (int o = 8; o < 64; o <<= 1) { mx.x = fmaxf(mx.x, __shfl_xor(mx.x, o)); mx.y = fmaxf(mx.y, __shfl_xor(mx.y, o)); mx.z = fmaxf(mx.z, __shfl_xor(mx.z, o)); mx.w = fmaxf(mx.w, __shfl_xor(mx.w, o)); }
    if (lane < 8) { atomicMax(cmx + cq, __float_as_uint(mx.x)); atomicMax(cmx + cq + 1, __float_as_uint(mx.y)); atomicMax(cmx + cq + 2, __float_as_uint(mx.z)); atomicMax(cmx + cq + 3, __float_as_uint(mx.w)); }
}
__device__ __forceinline__ void p0_transpose8_item(const float* W, int ldw, int scol0, int k0, unsigned char* WT, int drow0, const unsigned* cmx, LAS float* scr, int lane, const float* kscale = nullptr, int ldk = 2048) {
    {   const int rr = lane >> 3, cq = (lane & 7) * 4; f32x4 v[8];
#pragma unroll
        for (int i = 0; i < 8; ++i) v[i] = *(const f32x4*)(W + (size_t)(k0 + 8 * i + rr) * ldw + scol0 + cq);
#pragma unroll
        for (int i = 0; i < 8; ++i) { const int kk = 8 * i + rr; const float ks = kscale ? kscale[k0 + kk] : 1.0f; scr[kk * 33 + cq] = v[i].x * ks; scr[kk * 33 + cq + 1] = v[i].y * ks; scr[kk * 33 + cq + 2] = v[i].z * ks; scr[kk * 33 + cq + 3] = v[i].w * ks; }
    }
    asm volatile("s_waitcnt lgkmcnt(0)" ::: "memory");
    const int c = lane & 7;
#pragma unroll
    for (int j = 0; j < 4; ++j) { const int n = (lane >> 3) + 8 * j; const LAS float* sp = scr + (8 * c) * 33 + n;
        const float cm = __uint_as_float(cmx[n]); const float inv = cm > 0.f ? 127.0f / cm : 0.f;
        unsigned p0 = 0u, p1 = 0u;
#pragma unroll
        for (int x = 0; x < 4; ++x) { p0 |= (unsigned)((int)rintf(sp[x * 33] * inv) & 255) << (8 * x); p1 |= (unsigned)((int)rintf(sp[(4 + x) * 33] * inv) & 255) << (8 * x); }
        u32x2 o; o.x = p0; o.y = p1;
        *(u32x2*)(WT + (size_t)(drow0 + n) * ldk + k0 + 8 * c) = o; }
    asm volatile("s_waitcnt lgkmcnt(0)" ::: "memory");
}

__device__ __forceinline__ void row_to_mx4(const float* xrow, unsigned char* wd4, unsigned char* wds, int e, int lane) {
    float v[32]; float mx = 0.f;
#pragma unroll
    for (int q = 0; q < 8; ++q) { const f32x4 x = *(const f32x4*)(xrow + 32 * lane + 4 * q); v[4 * q] = x.x; v[4 * q + 1] = x.y; v[4 * q + 2] = x.z; v[4 * q + 3] = x.w;
        mx = fmaxf(mx, fmaxf(fmaxf(fabsf(x.x), fabsf(x.y)), fmaxf(fabsf(x.z), fabsf(x.w)))); }
    mx = fmaxf(mx, __shfl_xor(mx, 1)); mx = fmaxf(mx, __shfl_xor(mx, 2)); mx = fmaxf(mx, __shfl_xor(mx, 4));
    const unsigned scb = pk2(mx * (1.0f / 6.0f), 0.f) & 0xffffu;
    const float scr_ = __uint_as_float(scb << 16);
    const float inv = scr_ > 0.f ? 1.0f / scr_ : 0.f;
    unsigned w[4] = {0u, 0u, 0u, 0u};
#pragma unroll
    for (int i = 0; i < 32; ++i) { const float a = fabsf(v[i]) * inv;
        const unsigned c = (unsigned)(a > 0.25f) + (unsigned)(a > 0.75f) + (unsigned)(a > 1.25f) + (unsigned)(a > 1.75f) + (unsigned)(a > 2.5f) + (unsigned)(a > 3.5f) + (unsigned)(a > 5.0f);
        w[i >> 3] |= (c | ((__float_as_uint(v[i]) >> 28) & 8u)) << (4 * (i & 7)); }
    const int sl = lane >> 3, b = lane & 7;
    *(u32x4*)(wd4 + ((size_t)sl * 16384 + e) * 128 + b * 16) = (u32x4){w[0], w[1], w[2], w[3]};
    if (b == 0) *(bf16_t*)(wds + (size_t)e * 16 + 2 * sl) = (bf16_t)scb;
}
struct Args { const float* in[19]; float* out; unsigned char* ws; int ph_lo, ph_hi, li, pad; };

template <int TPW>
__device__ __forceinline__ void p0_strip8(const float* W, int ldw, int scol0, const float* kscale, unsigned char* WT, int drow0, int ldk, unsigned* cmx_out, LAS unsigned char* lds, int wave, int lane) {
    LAS float* scr = (LAS float*)(lds + wave * 16384);
    LAS unsigned* cml = (LAS unsigned*)(lds + LDSCTL_OFF + 4096);
    const int rr = lane >> 3, cq = (lane & 7) * 4;
    f32x4 v[TPW][8];
    {
        const __amdgpu_buffer_rsrc_t rw = __builtin_amdgcn_make_buffer_rsrc((void*)W, 0, 0x7FFFFFFF, 0x00020000);
        const int vo = (rr * ldw + cq) * 4;
#pragma unroll
        for (int i = 0; i < TPW; ++i)
#pragma unroll
            for (int r8 = 0; r8 < 8; ++r8) v[i][r8] = __builtin_bit_cast(f32x4, __builtin_amdgcn_raw_buffer_load_b128(rw, vo, ((64 * (wave + 8 * i) + 8 * r8) * ldw + scol0) * 4, 0));
    }
    if (wave == 0 && lane < 32) cml[lane] = 0u;
    f32x4 mx = {0.f, 0.f, 0.f, 0.f};
#pragma unroll
    for (int i = 0; i < TPW; ++i)
#pragma unroll
        for (int r8 = 0; r8 < 8; ++r8) { if (kscale) v[i][r8] = v[i][r8] * kscale[64 * (wave + 8 * i) + 8 * r8 + rr];
            mx.x = fmaxf(mx.x, fabsf(v[i][r8].x)); mx.y = fmaxf(mx.y, fabsf(v[i][r8].y)); mx.z = fmaxf(mx.z, fabsf(v[i][r8].z)); mx.w = fmaxf(mx.w, fabsf(v[i][r8].w)); }
#pragma unroll
    for (int o = 8; o < 64; o <<= 1) { mx.x = fmaxf(mx.x, __shfl_xor(mx.x, o)); mx.y = fmaxf(mx.y, __shfl_xor(mx.y, o)); mx.z = fmaxf(mx.z, __shfl_xor(mx.z, o)); mx.w = fmaxf(mx.w, __shfl_xor(mx.w, o)); }
    __syncthreads();
    if (lane < 8) {
        (void)__hip_atomic_fetch_max(cml + cq, __float_as_uint(mx.x), __ATOMIC_RELAXED, __HIP_MEMORY_SCOPE_WORKGROUP); (void)__hip_atomic_fetch_max(cml + cq + 1, __float_as_uint(mx.y), __ATOMIC_RELAXED, __HIP_MEMORY_SCOPE_WORKGROUP);
        (void)__hip_atomic_fetch_max(cml + cq + 2, __float_as_uint(mx.z), __ATOMIC_RELAXED, __HIP_MEMORY_SCOPE_WORKGROUP); (void)__hip_atomic_fetch_max(cml + cq + 3, __float_as_uint(mx.w), __ATOMIC_RELAXED, __HIP_MEMORY_SCOPE_WORKGROUP); }
    __syncthreads();
    if (wave == 0 && lane < 32) cmx_out[lane] = cml[lane];
    float inv[4];
#pragma unroll
    for (int j = 0; j < 4; ++j) { const float cm = __uint_as_float(cml[(lane >> 3) + 8 * j]); inv[j] = cm > 0.f ? 127.0f / cm : 0.f; }
    const int c = lane & 7;
#pragma unroll
    for (int i = 0; i < TPW; ++i) { const int k0 = 64 * (wave + 8 * i);
#pragma unroll
        for (int r8 = 0; r8 < 8; ++r8) { const int kk = 8 * r8 + rr; scr[kk * 33 + cq] = v[i][r8].x; scr[kk * 33 + cq + 1] = v[i][r8].y; scr[kk * 33 + cq + 2] = v[i][r8].z; scr[kk * 33 + cq + 3] = v[i][r8].w; }
        asm volatile("s_waitcnt lgkmcnt(0)" ::: "memory");
#pragma unroll
        for (int j = 0; j < 4; ++j) { const int n = (lane >> 3) + 8 * j; const LAS float* sp = scr + (8 * c) * 33 + n;
            unsigned p0 = 0u, p1 = 0u;
#pragma unroll
            for (int x = 0; x < 4; ++x) { p0 |= (unsigned)((int)rintf(sp[x * 33] * inv[j]) & 255) << (8 * x); p1 |= (unsigned)((int)rintf(sp[(4 + x) * 33] * inv[j]) & 255) << (8 * x); }
            u32x2 o; o.x = p0; o.y = p1;
            *(u32x2*)(WT + (size_t)(drow0 + n) * ldk + k0 + 8 * c) = o; }
        asm volatile("s_waitcnt lgkmcnt(0)" ::: "memory");
    }
    __syncthreads();
}

__device__ __forceinline__ void p0_prologue(const Args& A, LAS unsigned char* lds, int vcu, int G, int wave, int lane, int tid) {
    unsigned char* ws = A.ws;
    LAS float* scr = (LAS float*)(lds + wave * 16384);
    const int gw = vcu * NWAVES + wave, NGW = G * NWAVES;
    constexpr int I_WIN = 0, I_KV = 32 * 64, I_WB = 0, I_WO = 0, I_WQ = 0;
    constexpr int NT = I_WIN + I_KV + I_WB + I_WO + I_WQ;
    for (int it = gw; it < NT; it += NGW) {
        int r = it;
        if (r < I_WIN) { const int kb = r / 160, nb = r % 160; p0_transpose_item(A.in[4], DIN, win_src_col(32 * nb), 64 * kb, (bf16_t*)(ws + WS_WIN), 32 * nb, 2048, nullptr, scr, lane); continue; } r -= I_WIN;
        if (r < I_KV) { const int kb = r / 64, nb = r % 64; p0_transpose_item(A.in[10], 2048, 32 * nb, 64 * kb, (bf16_t*)(ws + WS_WKV), 32 * nb, 2048, nullptr, scr, lane); continue; } r -= I_KV;
        if (r < I_WB) { const int n = r / 1024, rr = r % 1024, kb = rr / 64, nb = rr % 64;
            p0_transpose_item(A.in[11] + (size_t)n * 1024 * 2048, 2048, 32 * nb, 64 * kb, (bf16_t*)(ws + WS_WB) + (size_t)n * 2048 * 1024, 32 * nb, 1024, nullptr, scr, lane); continue; } r -= I_WB;
        if (r < I_WO) { const int kb = r / 64, nb = r % 64; p0_transpose_item(A.in[12], 2048, 32 * nb, 64 * kb, (bf16_t*)(ws + WS_WOUT), 32 * nb, 2048, nullptr, scr, lane); continue; } r -= I_WO;
        { const int kb = r / 64, nb = r % 64; p0_transpose_item(A.in[14], 2048, 32 * nb, 64 * kb, (bf16_t*)(ws + WS_WQ), 32 * nb, 2048, A.in[13], scr, lane); }
    }
    for (int r = gw; r < M + MM; r += NGW) {
        if (r < M) row_h1(A.in[0] + (size_t)r * 2048, ws + WS_H8 + (size_t)r * 2048, (float*)(ws + WS_HS) + r, A.in[2], lane);
        else if (r < M + MM) { const int q = r - M; row_to_bf16(A.in[1] + (size_t)q * 2048, (bf16_t*)(ws + WS_MEMN) + (size_t)q * 2048, A.in[3], lane); }
    }
    for (int it = vcu; it < 384 + 64 + 64 + 192; it += G) {
        if (it < 384) p0_strip8<4>(A.in[4], DIN, win_src_col(32 * it), nullptr, ws + WS_W8, 32 * it, 2048, (unsigned*)(ws + WS_CTL + CTL_CMX) + 32 * it, lds, wave, lane);
        else if (it < 448) { const int nb = it - 384; p0_strip8<4>(A.in[12], 2048, 32 * nb, nullptr, ws + WS_WOUT, 32 * nb, 2048, (unsigned*)(ws + WS_CTL + CTL_CMXO) + 32 * nb, lds, wave, lane); }
        else if (it < 512) { const int nb = it - 448; p0_strip8<4>(A.in[14], 2048, 32 * nb, A.in[13], ws + WS_WQ, 32 * nb, 2048, (unsigned*)(ws + WS_CTL + CTL_CMXQ) + 32 * nb, lds, wave, lane); }
        else { const int s_ = it - 512, n = s_ / 64, nb = s_ % 64;
            p0_strip8<2>(A.in[11] + (size_t)n * 1024 * 2048, 2048, 32 * nb, nullptr, ws + WS_WB + (size_t)n * 2048 * 1024, 32 * nb, 1024, (unsigned*)(ws + WS_CTL + CTL_CMXB) + n * 2048 + 32 * nb, lds, wave, lane); }
    }
    const int gt = vcu * 512 + tid, NGT = G * 512;
    for (int o = gt; o < 32768; o += NGT) {
        const int ln = o & 63, s = (o >> 6) & 7, kb = (o >> 9) & 3, hp = o >> 11;
        const float* src = A.in[15] + ((size_t)hp * 128 + 32 * kb + (ln & 31)) * 128 + 16 * s + 8 * (ln >> 5);
        const f32x4 a = *(const f32x4*)src, b = *(const f32x4*)(src + 4);
        *(u32x4*)((bf16_t*)(ws + WS_KEYF) + (size_t)o * 8) = pack8(a, b);
    }
    for (int o = gt; o < 16384; o += NGT) {
        const int j0 = (o & 15) * 8, i = (o >> 4) & 127;
        const float* src = A.in[5] + (size_t)o * 8;
        f32x4 a = *(const f32x4*)src, b = *(const f32x4*)(src + 4);
        if ((j0 >> 6) > (i >> 6)) { a = (f32x4){0.f, 0.f, 0.f, 0.f}; b = a; }
        *(u32x4*)((bf16_t*)(ws + WS_WSM) + (size_t)o * 8) = pack8(a, b);
    }
}

__device__ __forceinline__ void p0b_convert(const Args& A, LAS unsigned char* lds, int rank, int nranks, int wave, int lane) {
    unsigned char* ws = A.ws; LAS float* scr = (LAS float*)(lds + wave * 16384);
    const int gw = rank * NWAVES + wave, NGW = nranks * NWAVES;
    for (int q = gw; q < 16384; q += NGW) row_to_mx4(A.in[16] + (size_t)q * 2048, ws + WS_WD4, ws + WS_WDS, q, lane);
    for (int q = gw; q < 16384; q += NGW) row_to_fp4u(A.in[17] + (size_t)q * 2048, ws + WS_WU4, (float*)(ws + WS_SCU) + q, q, lane);
}

__device__ __forceinline__ void p2_gmlp_block(const Args& A, LAS unsigned char* lds, int blk, int wave, int lane, int tid) {
    unsigned char* ws = A.ws;
    const bf16_t* GA = (const bf16_t*)(ws + WS_GA); bf16_t* YA = (bf16_t*)(ws + WS_YA); const bf16_t* WSM = (const bf16_t*)(ws + WS_WSM);
    const float *b_s = A.in[6], *ln_g = A.in[7], *ln_b = A.in[8];
    LAS float* stat = (LAS float*)lds;
    LAS bf16_t* vT = (LAS bf16_t*)(lds + 1024);
    const int r0 = blk * 128, hh = lane >> 5, r = lane & 31;
    for (int r4 = 0; r4 < 16; r4 += 4) {
        u32x4 a[4], b[4];
#pragma unroll
        for (int k = 0; k < 4; ++k) { const bf16_t* vp = GA + (size_t)(r0 + wave * 16 + r4 + k) * 2048 + 1024 + lane * 8; a[k] = *(const u32x4*)vp; b[k] = *(const u32x4*)(vp + 512); }
#pragma unroll
        for (int k = 0; k < 4; ++k) { float s = 0.f, q = 0.f;
#pragma unroll
            for (int j = 0; j < 4; ++j) { const float x0 = bf_lo(a[k][j]), x1 = bf_hi(a[k][j]), y0 = bf_lo(b[k][j]), y1 = bf_hi(b[k][j]); s += (x0 + x1) + (y0 + y1); q += (x0 * x0 + x1 * x1) + (y0 * y0 + y1 * y1); }
            s = wave_sum(s); q = wave_sum(q);
            const float mean = s * (1.0f / 1024.0f), var = q * (1.0f / 1024.0f) - mean * mean;
            if (lane == 0) { stat[2 * (wave * 16 + r4 + k)] = mean; stat[2 * (wave * 16 + r4 + k) + 1] = __builtin_amdgcn_rsqf(var + EPS); } }
    }
    __syncthreads();
    constexpr int VTB = 128 * 136;
#pragma unroll 1
    for (int g0 = 0; g0 < 8; g0 += 3) {
        const int ng = (8 - g0) < 3 ? (8 - g0) : 3;
        {
            const int j = tid >> 2, cc = (tid & 3) * 32; const float mu = stat[2 * j], rstd = stat[2 * j + 1];
            u32x4 av[3][4];
#pragma unroll
            for (int gl = 0; gl < 3; ++gl) if (gl < ng) { const bf16_t* vp = GA + (size_t)(r0 + j) * 2048 + 1024 + (g0 + gl) * 128 + cc;
#pragma unroll
                for (int k4 = 0; k4 < 4; ++k4) av[gl][k4] = *(const u32x4*)(vp + 8 * k4); }
#pragma unroll
            for (int gl = 0; gl < 3; ++gl) if (gl < ng) { LAS bf16_t* vt = vT + gl * VTB;
#pragma unroll
                for (int k4 = 0; k4 < 4; ++k4) { const u32x4 a = av[gl][k4]; const int ch = (g0 + gl) * 128 + cc + 8 * k4;
                    const f32x4 gg0 = *(const f32x4*)(ln_g + ch), gg1 = *(const f32x4*)(ln_g + ch + 4), bb0 = *(const f32x4*)(ln_b + ch), bb1 = *(const f32x4*)(ln_b + ch + 4);
#pragma unroll
                    for (int x = 0; x < 4; ++x) { const float lo = (bf_lo(a[x]) - mu) * rstd * (x < 2 ? gg0[2 * x] : gg1[2 * x - 4]) + (x < 2 ? bb0[2 * x] : bb1[2 * x - 4]);
                        const float hi = (bf_hi(a[x]) - mu) * rstd * (x < 2 ? gg0[2 * x + 1] : gg1[2 * x - 3]) + (x < 2 ? bb0[2 * x + 1] : bb1[2 * x - 3]);
                        const unsigned p = pk2(lo, hi);
                        vt[(cc + 8 * k4 + 2 * x) * 136 + j] = (bf16_t)(p & 0xffffu); vt[(cc + 8 * k4 + 2 * x + 1) * 136 + j] = (bf16_t)(p >> 16); } } }
        }
        __syncthreads();
#pragma unroll 1
        for (int gl = 0; gl < ng; ++gl) {
            const int grp = g0 + gl; const LAS bf16_t* vt = vT + gl * VTB;
            const int cb = wave >> 1, ib0 = 2 * (wave & 1);
            f32x16 acc[2];
#pragma unroll
            for (int q = 0; q < 2; ++q)
#pragma unroll
                for (int e = 0; e < 16; ++e) acc[q][e] = 0.f;
            u32x2 uu8[2][4]; float bias2[2];
#pragma unroll
            for (int q = 0; q < 2; ++q) { const int i = (ib0 + q) * 32 + r, row = r0 + i; bias2[q] = b_s[grp * 128 + i];
#pragma unroll
                for (int g4 = 0; g4 < 4; ++g4) uu8[q][g4] = *(const u32x2*)(GA + (size_t)row * 2048 + grp * 128 + cb * 32 + 8 * g4 + 4 * hh); }
#pragma unroll
            for (int s = 0; s < 8; ++s) {
                const bf16x8 a = *(const LAS bf16x8*)(vt + (cb * 32 + r) * 136 + 16 * s + 8 * hh);
#pragma unroll
                for (int q = 0; q < 2; ++q) { const bf16x8 b = *(const bf16x8*)(WSM + ((size_t)grp * 128 + (ib0 + q) * 32 + r) * 128 + 16 * s + 8 * hh); acc[q] = MFMA32(a, b, acc[q]); }
            }
#pragma unroll
            for (int q = 0; q < 2; ++q) { const int i = (ib0 + q) * 32 + r, row = r0 + i; const float bias = bias2[q];
#pragma unroll
                for (int g4 = 0; g4 < 4; ++g4) { const int col = grp * 128 + cb * 32 + 8 * g4 + 4 * hh;
                    const u32x2 uu = uu8[q][g4];
                    u32x2 w; w.x = pk2((acc[q][4 * g4] + bias) * bf_lo(uu.x), (acc[q][4 * g4 + 1] + bias) * bf_hi(uu.x));
                    w.y = pk2((acc[q][4 * g4 + 2] + bias) * bf_lo(uu.y), (acc[q][4 * g4 + 3] + bias) * bf_hi(uu.y));
                    *(u32x2*)(YA + (size_t)row * 1024 + col) = w; } }
        }
        __syncthreads();
    }
}
__device__ __forceinline__ void p2_conv(const Args& A, LAS unsigned char* lds, int vcu, int G, int tid) {
    unsigned char* ws = A.ws; const bf16_t* BG = (const bf16_t*)(ws + WS_BG); const bf16_t* CH = (const bf16_t*)(ws + WS_CH); const float* cw = A.in[9];
    unsigned char* Y8 = ws + WS_A81; float* RA1 = (float*)(ws + WS_RA) + M;
    LAS float* part = (LAS float*)(lds + LDSCTL_OFF + 4096);
    const int stride = G * 512, wave_ = tid >> 6, lane_ = tid & 63;
    const int c = ((vcu * 512 + tid) & 127) * 8;
    const f32x4 w0a = *(const f32x4*)(cw + c), w0b = *(const f32x4*)(cw + c + 4), w1a = *(const f32x4*)(cw + 1024 + c), w1b = *(const f32x4*)(cw + 1024 + c + 4), w2a = *(const f32x4*)(cw + 2048 + c), w2b = *(const f32x4*)(cw + 2048 + c + 4);
    for (int idx0 = vcu * 512 + tid; idx0 < M * 128; idx0 += 4 * stride) {
        u32x4 c0[4], c1[4], c2[4], bg[4];
#pragma unroll
        for (int k = 0; k < 4; ++k) { const int idx = idx0 + k * stride; const bool ok = idx < M * 128; const int t = ok ? idx >> 7 : 0, s = t & (SEQ - 1);
            const size_t o = (size_t)t * 1024 + c; const u32x4 z = {0u, 0u, 0u, 0u};
            c0[k] = *(const u32x4*)(CH + o); c1[k] = s >= 1 ? *(const u32x4*)(CH + o - 1024) : z; c2[k] = s >= 2 ? *(const u32x4*)(CH + o - 2048) : z; bg[k] = *(const u32x4*)(BG + o); }
        float yv[4][8], mx[4];
#pragma unroll
        for (int k = 0; k < 4; ++k) { mx[k] = 0.f;
#pragma unroll
            for (int x = 0; x < 4; ++x) { const float wl0 = x < 2 ? w0a[2 * x] : w0b[2 * x - 4], wh0 = x < 2 ? w0a[2 * x + 1] : w0b[2 * x - 3], wl1 = x < 2 ? w1a[2 * x] : w1b[2 * x - 4], wh1 = x < 2 ? w1a[2 * x + 1] : w1b[2 * x - 3], wl2 = x < 2 ? w2a[2 * x] : w2b[2 * x - 4], wh2 = x < 2 ? w2a[2 * x + 1] : w2b[2 * x - 3];
                const float lo = bf_lo(bg[k][x]) * (wl0 * bf_lo(c2[k][x]) + wl1 * bf_lo(c1[k][x]) + wl2 * bf_lo(c0[k][x]));
                const float hi = bf_hi(bg[k][x]) * (wh0 * bf_hi(c2[k][x]) + wh1 * bf_hi(c1[k][x]) + wh2 * bf_hi(c0[k][x]));
                yv[k][2 * x] = lo; yv[k][2 * x + 1] = hi; mx[k] = fmaxf(mx[k], fmaxf(fabsf(lo), fabsf(hi))); }
#pragma unroll
            for (int o = 1; o < 64; o <<= 1) mx[k] = fmaxf(mx[k], __shfl_xor(mx[k], o));
            if (lane_ == 0) part[k * 8 + wave_] = mx[k]; }
        __syncthreads();
#pragma unroll
        for (int k = 0; k < 4; ++k) { const int idx = idx0 + k * stride; const float rmax = fmaxf(part[k * 8 + wave_], part[k * 8 + (wave_ ^ 1)]); const float inv = rmax > 0.f ? 127.0f / rmax : 0.f;
            if (idx < M * 128) { const int t = idx >> 7; u32x2 o;
#pragma unroll
                for (int h = 0; h < 2; ++h) { const int a = (int)rintf(yv[k][4 * h] * inv), b = (int)rintf(yv[k][4 * h + 1] * inv), cc = (int)rintf(yv[k][4 * h + 2] * inv), d = (int)rintf(yv[k][4 * h + 3] * inv);
                    o[h] = (unsigned)(a & 255) | ((unsigned)(b & 255) << 8) | ((unsigned)(cc & 255) << 16) | ((unsigned)(d & 255) << 24); }
                *(u32x2*)(Y8 + (size_t)t * 1024 + c) = o;
                if ((tid & 127) == 0) RA1[t] = rmax > 0.f ? rmax * (1.0f / 127.0f) : 1.0f; } }
        __syncthreads();
    }
}
__device__ __forceinline__ void p2_attn_copy(LAS unsigned char* lds, const unsigned char* src, int tid) {
    const u32x4* s4 = (const u32x4*)src + tid;
#pragma unroll
    for (int hlf = 0; hlf < 2; ++hlf) {
        u32x4 v[8];
#pragma unroll
        for (int i = 0; i < 8; ++i) v[i] = s4[(hlf * 8 + i) * 512];
#pragma unroll
        for (int i = 0; i < 8; ++i) *(LAS u32x4*)(lds + (size_t)((hlf * 8 + i) * 512 + tid) * 16) = v[i];
        asm volatile("" ::: "memory");
    }
}
__device__ __forceinline__ void p2_attn_unit(const Args& A, LAS unsigned char* lds, int b, int h, int q0, int lane, int tid) {
    asm volatile("" : "+v"(lane), "+v"(tid));
    unsigned char* ws = A.ws; const bf16_t* Q = (const bf16_t*)(ws + WS_Q); bf16_t* YC = (bf16_t*)(ws + WS_YC);
    const unsigned char* KFg = ws + WS_KF + (size_t)(b * 4 + h) * 131072; const unsigned char* VFg = ws + WS_VF + (size_t)(b * 4 + h) * 131072;
    const LAS bf16x8* FL = (const LAS bf16x8*)lds + lane; const LAS bf16x8* FH = FL + 4096;
    const int r = lane & 31, hh = lane >> 5;
    const size_t trow = (size_t)(b * SEQ + q0 + r) * 1024 + h * 256;
    __syncthreads();
    p2_attn_copy(lds, KFg, tid);
    __syncthreads();
    f32x16 acc[8];
#pragma unroll
    for (int kb = 0; kb < 8; ++kb)
#pragma unroll
        for (int e = 0; e < 16; ++e) acc[kb][e] = 0.f;
#pragma unroll 2
    for (int s = 0; s < 16; ++s) {
        const bf16x8 qf = *(const bf16x8*)(Q + trow + 16 * s + 8 * hh);
#pragma unroll
        for (int kb = 0; kb < 8; ++kb) acc[kb] = MFMA32((kb < 4 ? FL : FH)[((kb & 3) * 16 + s) * 64], qf, acc[kb]);
    }
    constexpr float C1 = 0.0625f * 1.44269504f;
    float mx = -3.0e38f;
#pragma unroll
    for (int kb = 0; kb < 8; ++kb)
#pragma unroll
        for (int e = 0; e < 16; ++e) mx = fmaxf(mx, acc[kb][e]);
    mx = fmaxf(mx, __shfl_xor(mx, 32));
    const float mc = mx * C1; float l = 0.f;
#pragma unroll
    for (int kb = 0; kb < 8; ++kb)
#pragma unroll
        for (int e = 0; e < 16; ++e) { const float p = __builtin_amdgcn_exp2f(acc[kb][e] * C1 - mc); acc[kb][e] = p; l += p; }
    l += __shfl_xor(l, 32);
    bf16x8 pf[16];
#pragma unroll
    for (int kb = 0; kb < 8; ++kb)
#pragma unroll
        for (int s = 0; s < 2; ++s) { u32x4 w; w.x = pk2(acc[kb][8 * s], acc[kb][8 * s + 1]); w.y = pk2(acc[kb][8 * s + 2], acc[kb][8 * s + 3]); w.z = pk2(acc[kb][8 * s + 4], acc[kb][8 * s + 5]); w.w = pk2(acc[kb][8 * s + 6], acc[kb][8 * s + 7]);
            pf[kb * 2 + s] = __builtin_bit_cast(bf16x8, w); }
    const float inv = 1.0f / l;
    __syncthreads();
    p2_attn_copy(lds, VFg, tid);
    __syncthreads();
    int l2 = lane; asm volatile("" : "+v"(l2));
    const size_t orow = (size_t)(b * SEQ + q0 + (l2 & 31)) * 1024 + h * 256 + 4 * (l2 >> 5);
#pragma unroll 1
    for (int db = 0; db < 8; ++db) {
        f32x16 od;
#pragma unroll
        for (int e = 0; e < 16; ++e) od[e] = 0.f;
#pragma unroll
        for (int ks = 0; ks < 16; ++ks) od = MFMA32(FL[(db * 16 + ks) * 64], pf[ks], od);
#pragma unroll
        for (int g4 = 0; g4 < 4; ++g4) { u32x2 w; w.x = pk2(od[4 * g4] * inv, od[4 * g4 + 1] * inv); w.y = pk2(od[4 * g4 + 2] * inv, od[4 * g4 + 3] * inv);
            *(u32x2*)(YC + orow + 32 * db + 8 * g4) = w; }
    }
}

__device__ __forceinline__ unsigned ord_u(float f) { const unsigned b = __float_as_uint(f); return b ^ ((unsigned)((int)b >> 31) | 0x80000000u); }
__device__ __forceinline__ float unord_f(unsigned u) { return __uint_as_float(u ^ ((u & 0x80000000u) ? 0x80000000u : 0xFFFFFFFFu)); }
#define TOPK_INS(L, xx) do { unsigned _x = (xx); _Pragma("unroll") for (int _j = 0; _j < 16; ++_j) { const unsigned _hi = L[_j] > _x ? L[_j] : _x; _x = L[_j] > _x ? _x : L[_j]; L[_j] = _hi; } } while (0)
__device__ __forceinline__ void bitonic_sort16_desc(u32x16& v) {
#pragma unroll
    for (int k = 2; k <= 16; k <<= 1)
#pragma unroll
        for (int j = k >> 1; j > 0; j >>= 1)
#pragma unroll
            for (int i = 0; i < 16; ++i) { const int l = i ^ j; if (l > i) { const unsigned a = v[i], b = v[l], hi = a > b ? a : b, lo = a > b ? b : a; const bool desc = ((i & k) == 0); v[i] = desc ? hi : lo; v[l] = desc ? lo : hi; } }
}
__device__ __forceinline__ void bitonic_merge16_desc(u32x16& v) {
#pragma unroll
    for (int j = 8; j > 0; j >>= 1)
#pragma unroll
        for (int i = 0; i < 16; ++i) { const int l = i ^ j; if (l > i) { const unsigned a = v[i], b = v[l]; v[i] = a > b ? a : b; v[l] = a > b ? b : a; } }
}
__device__ __forceinline__ void top16_merge(u32x16& A, const u32x16 B) {
#pragma unroll
    for (int i = 0; i < 16; ++i) { const unsigned a = A[i], b = B[15 - i]; A[i] = a > b ? a : b; }
    bitonic_merge16_desc(A);
}
__device__ __forceinline__ unsigned sel16(const u32x16 T, unsigned i) {
    unsigned a[8], b[4], c[2];
    const unsigned m0 = 0u - (i & 1u), m1 = 0u - ((i >> 1) & 1u), m2 = 0u - ((i >> 2) & 1u), m3 = 0u - ((i >> 3) & 1u);
#pragma unroll
    for (int q = 0; q < 8; ++q) a[q] = (T[2 * q + 1] & m0) | (T[2 * q] & ~m0);
#pragma unroll
    for (int q = 0; q < 4; ++q) b[q] = (a[2 * q + 1] & m1) | (a[2 * q] & ~m1);
#pragma unroll
    for (int q = 0; q < 2; ++q) c[q] = (b[2 * q + 1] & m2) | (b[2 * q] & ~m2);
    return (c[1] & m3) | (c[0] & ~m3);
}
__device__ __forceinline__ void p6_half(const LAS unsigned char* kl, const bf16x8 (&qf)[8], int lane, u32x16& L) {
    const int hh = lane >> 5;
    f32x16 acc[4];
#pragma unroll
    for (int kb = 0; kb < 4; ++kb) {
#pragma unroll
        for (int e = 0; e < 16; ++e) acc[kb][e] = 0.f;
#pragma unroll
        for (int s = 0; s < 8; ++s) acc[kb] = MFMA32(*(const LAS bf16x8*)(kl + ((kb * 8 + s) * 64 + lane) * 16), qf[s], acc[kb]);
    }
    const unsigned nh4 = hh ? 0u : 4u;
    u32x16 X[4];
#pragma unroll
    for (int kb = 0; kb < 4; ++kb) {
#pragma unroll
        for (int e = 0; e < 16; ++e) {
            const unsigned kc = (unsigned)(32 * kb + (e & 3) + 8 * (e >> 2));
            X[kb][e] = (ord_u(acc[kb][e]) & ~127u) | ((~kc) & 0x7Bu) | nh4;
        }
        bitonic_sort16_desc(X[kb]);
    }
    top16_merge(X[0], X[1]); top16_merge(X[2], X[3]); top16_merge(X[0], X[2]);
    L = X[0];
    u32x16 P;
#pragma unroll
    for (int j = 0; j < 16; ++j) P[j] = (unsigned)__shfl_xor((int)L[j], 32);
    top16_merge(L, P);
}
__device__ __forceinline__ void p6_tile(const Args& A, LAS unsigned char* keys_lds, int head, int t0, int wave, int lane) {
    unsigned char* ws = A.ws;
    const int r = lane & 31, hh = lane >> 5, t = t0 + r;
    const bf16_t* pq = (const bf16_t*)(ws + WS_PQ) + (size_t)t * 2048 + head * 256;
    u32x16 L1, L2;
    const f32x4* sp = (const f32x4*)((const float*)(ws + WS_SSP) + (size_t)t * 32);
    f32x4 spv[8];
#pragma unroll
    for (int j = 0; j < 8; ++j) spv[j] = sp[j];
    bf16x8 qa[8], qb[8];
#pragma unroll
    for (int s = 0; s < 8; ++s) { qa[s] = *(const bf16x8*)(pq + 16 * s + 8 * hh); qb[s] = *(const bf16x8*)(pq + 128 + 16 * s + 8 * hh); }
    float ss = 0.f;
#pragma unroll
    for (int j = 0; j < 8; ++j) ss += (spv[j].x + spv[j].y) + (spv[j].z + spv[j].w);
    p6_half(keys_lds, qa, lane, L1);
    p6_half(keys_lds + 32768, qb, lane, L2);
    f32x16 sa, sb;
#pragma unroll
    for (int j = 0; j < 16; ++j) { sa[j] = unord_f(L1[j] & ~127u); sb[j] = unord_f(L2[j] & ~127u); }
    u32x16 CG[4];
#pragma unroll
    for (int q = 0; q < 4; ++q)
#pragma unroll
        for (int j = 0; j < 16; ++j) CG[q][j] = 0u;
    {
        int cnt = 0;
#pragma unroll
        for (int i = 0; i < 16; ++i)
#pragma unroll
            for (int j = 0; j < 16; ++j) if ((i + 1) * (j + 1) <= 16) { CG[cnt >> 4][cnt & 15] = (ord_u(sa[i] + sb[j]) & ~255u) | (unsigned)(255 - (i * 16 + j)); ++cnt; }
    }
#pragma unroll
    for (int q = 0; q < 4; ++q) bitonic_sort16_desc(CG[q]);
    top16_merge(CG[0], CG[1]); top16_merge(CG[2], CG[3]); top16_merge(CG[0], CG[2]);
    const u32x16 C = CG[0];
    const float rs = __builtin_amdgcn_rsqf(ss * (1.0f / 2048.0f) + EPS) * 1.44269504f;
    if (head == 0 && hh == 0) ((float*)(ws + WS_RS))[t] = rs * (1.0f / 1.44269504f);
    LAS unsigned* lt = (LAS unsigned*)(keys_lds + 65536) + (wave * 32 + r) * 33;
#pragma unroll
    for (int j = 0; j < 16; ++j) { lt[j] = L1[j]; lt[16 + j] = L2[j]; }
    f32x16 ev; u32x16 ei; float den = 0.f; const float s0 = unord_f(C[0] & ~255u);
#pragma unroll
    for (int k = 0; k < 16; ++k) {
        const unsigned code = 255u - (C[k] & 255u);
        const float sv = unord_f(C[k] & ~255u);
        ev[k] = __builtin_amdgcn_exp2f((sv - s0) * rs); den += ev[k];
        const unsigned i1 = 127u - (lt[code >> 4] & 127u), i2 = 127u - (lt[16u + (code & 15u)] & 127u);
        ei[k] = i1 * 128u + i2;
    }
    const float inv = 1.0f / den;
    u32x4 oi[2]; f32x4 og[2];
#pragma unroll
    for (int j = 0; j < 8; ++j) { oi[j >> 2][j & 3] = hh ? ei[8 + j] : ei[j]; og[j >> 2][j & 3] = (hh ? ev[8 + j] : ev[j]) * inv; }
    const size_t o = (size_t)t * 128 + head * 16 + 8 * hh;
    u32x4* ip = (u32x4*)((unsigned*)(ws + WS_IDX) + o); ip[0] = oi[0]; ip[1] = oi[1];
    f32x4* gp = (f32x4*)((float*)(ws + WS_GW) + o); gp[0] = og[0]; gp[1] = og[1];
}

__device__ __forceinline__ float dpp_sum(float v) {
    int x = (int)__float_as_uint(v);
    v += __uint_as_float((unsigned)__builtin_amdgcn_update_dpp(0, x, 0xB1, 0xF, 0xF, false)); x = (int)__float_as_uint(v);
    v += __uint_as_float((unsigned)__builtin_amdgcn_update_dpp(0, x, 0x4E, 0xF, 0xF, false)); x = (int)__float_as_uint(v);
    v += __uint_as_float((unsigned)__builtin_amdgcn_update_dpp(0, x, 0x141, 0xF, 0xF, false)); x = (int)__float_as_uint(v);
    v += __uint_as_float((unsigned)__builtin_amdgcn_update_dpp(0, x, 0x140, 0xF, 0xF, false)); x = (int)__float_as_uint(v);
    v += __uint_as_float((unsigned)__builtin_amdgcn_update_dpp(0, x, 0x142, 0xA, 0xF, false)); x = (int)__float_as_uint(v);
    v += __uint_as_float((unsigned)__builtin_amdgcn_update_dpp(0, x, 0x143, 0xC, 0xF, false));
    return __uint_as_float((unsigned)__builtin_amdgcn_readlane((int)__float_as_uint(v), 63));
}
constexpr int P7_TB = 128;
__device__ __forceinline__ i32x8 p7x_a8(const u32x4 a) { return (i32x8){(int)a.x, (int)a.y, (int)a.z, (int)a.w, 0, 0, 0, 0}; }
__device__ __forceinline__ void p7x_wave(const Args& A, LAS unsigned char* lds, int wave, int lane_, int qset) {
    unsigned char* ws = A.ws;
    const __amdgpu_buffer_rsrc_t rsrc = __builtin_amdgcn_make_buffer_rsrc((void*)ws, 0, 0x7FFFFFFF, 0x00020000);
    int lane = lane_; asm volatile("" : "+v"(lane));
    LAS unsigned char* rowbuf = lds + wave * 16384;
    LAS unsigned char* hx = lds + LDSCTL_OFF + 4096 + wave * 512;
    const int r = lane & 15, g = lane >> 4, l3 = lane >> 3;
    const int fr = ((r >> 1) & 3) | ((r >> 3) << 2);
    const int rd0 = r * 128 + ((g ^ fr) << 4), rd1 = r * 128 + (((4 + g) ^ fr) << 4);
    const int f0 = (l3 >> 1) & 3;
    const int pc0 = ((lane & 7) ^ f0) << 4, pc1 = ((lane & 7) ^ (f0 | 4)) << 4;
    const int vo_a = l3 * 64, vo_x = lane * 8, vo_p = (16 * (r & 7) + 4 * g) * 2;
    int scg[8];
#pragma unroll
    for (int G_ = 0; G_ < 8; ++G_) scg[G_] = ((r & 7) == G_) ? 0x7F7F7F7F : 0;
    const int hb = (g << 4);
    unsigned* Q = (unsigned*)(ws + WS_CTL + CTL_P7Q) + qset * 512;
    const int xs = (int)(xb_xcc_id() & 7u);
#pragma unroll 1
    for (int k = 0; k < 8; ++k) {
        const int s = (xs + k) & 7;
        const f32x4 gs = *(const f32x4*)(A.in[13] + 256 * s + 4 * lane);
        const int so_w = (int)WS_WD4 + s * (16384 * 128);
#pragma unroll 1
        for (;;) {
            unsigned blk = 0u; if (lane == 0) blk = xb_add(Q + s * 64, 1u);
            blk = (unsigned)__builtin_amdgcn_readfirstlane((int)blk);
            if (blk >= (unsigned)(M / P7_TB)) break;
            const int t0 = (int)blk * P7_TB;
            u32x4 ea[4]; u32x2 xv; float rsv; i32x8 B0, B1, B2, B3;
#define P7X_IDX(tt) do { const int t_ = (tt); const int so_ = (int)WS_IDX + t_ * 512; \
            xv = __builtin_bit_cast(u32x2, __builtin_amdgcn_raw_buffer_load_b64(rsrc, vo_x, (int)WS_GA + t_ * 4096 + s * 512, 0)); \
            rsv = __uint_as_float((unsigned)__builtin_amdgcn_raw_buffer_load_b32(rsrc, 0, (int)WS_RS + t_ * 4, 0)); __builtin_amdgcn_sched_barrier(0); \
            _Pragma("unroll") for (int q_ = 0; q_ < 4; ++q_) ea[q_] = __builtin_bit_cast(u32x4, __builtin_amdgcn_raw_buffer_load_b128(rsrc, vo_a + 16 * q_, so_, 0)); } while (0)
#define P7X_HX() do { const float h0_ = bf_lo(xv.x) * rsv * gs.x, h1_ = bf_hi(xv.x) * rsv * gs.y, h2_ = bf_lo(xv.y) * rsv * gs.z, h3_ = bf_hi(xv.y) * rsv * gs.w; \
            int hi_ = __builtin_amdgcn_cvt_pk_fp8_f32(h0_, h1_, 0, false); hi_ = __builtin_amdgcn_cvt_pk_fp8_f32(h2_, h3_, hi_, true); \
            int lo_ = __builtin_amdgcn_cvt_pk_fp8_f32(h0_ - __builtin_amdgcn_cvt_f32_fp8(hi_, 0), h1_ - __builtin_amdgcn_cvt_f32_fp8(hi_, 1), 0, false); \
            lo_ = __builtin_amdgcn_cvt_pk_fp8_f32(h2_ - __builtin_amdgcn_cvt_f32_fp8(hi_, 2), h3_ - __builtin_amdgcn_cvt_f32_fp8(hi_, 3), lo_, true); \
            *(LAS int*)(hx + 4 * lane) = hi_; *(LAS int*)(hx + 256 + 4 * lane) = lo_; } while (0)
#define P7X_BLD() do { const u32x4 b0_ = *(const LAS u32x4*)(hx + hb), b1_ = *(const LAS u32x4*)(hx + hb + 64), b2_ = *(const LAS u32x4*)(hx + hb + 128), b3_ = *(const LAS u32x4*)(hx + hb + 192); \
            B0 = (i32x8){(int)b0_.x, (int)b0_.y, (int)b0_.z, (int)b0_.w, (int)b1_.x, (int)b1_.y, (int)b1_.z, (int)b1_.w}; \
            B1 = (i32x8){(int)b2_.x, (int)b2_.y, (int)b2_.z, (int)b2_.w, (int)b3_.x, (int)b3_.y, (int)b3_.z, (int)b3_.w}; \
            const u32x4 c0_ = *(const LAS u32x4*)(hx + hb + 256), c1_ = *(const LAS u32x4*)(hx + hb + 320), c2_ = *(const LAS u32x4*)(hx + hb + 384), c3_ = *(const LAS u32x4*)(hx + hb + 448); \
            B2 = (i32x8){(int)c0_.x, (int)c0_.y, (int)c0_.z, (int)c0_.w, (int)c1_.x, (int)c1_.y, (int)c1_.z, (int)c1_.w}; \
            B3 = (i32x8){(int)c2_.x, (int)c2_.y, (int)c2_.z, (int)c2_.w, (int)c3_.x, (int)c3_.y, (int)c3_.z, (int)c3_.w}; } while (0)
#define P7X_DMA() do { _Pragma("unroll") for (int i = 0; i < 16; ++i) __builtin_amdgcn_raw_ptr_buffer_load_lds(rsrc, (LAS void*)(rowbuf + i * 1024), 16, (int)(ea[i >> 2][i & 3] * 128u) + ((i & 1) ? pc1 : pc0), so_w, 0, 0); } while (0)
            P7X_IDX(t0);
            P7X_HX(); P7X_BLD();
            P7X_DMA();
            P7X_IDX(t0 + 1);
            __builtin_amdgcn_raw_buffer_store_b32(0u, rsrc, lane * 4, (int)WS_CTL + 950 * 1024, 0);
#pragma unroll 1
            for (int v = 0; v < P7_TB; ++v) {
                if (v == 0) asm volatile("s_waitcnt vmcnt(0)" ::: "memory"); else asm volatile("s_waitcnt vmcnt(1)" ::: "memory");
                if (v + 1 < P7_TB) P7X_HX();
                f32x4 acc0 = {0.f, 0.f, 0.f, 0.f}, acc1 = {0.f, 0.f, 0.f, 0.f};
#pragma unroll
                for (int G_ = 0; G_ < 8; ++G_) {
                    const u32x4 a0 = *(const LAS u32x4*)(rowbuf + G_ * 2048 + rd0), a1 = *(const LAS u32x4*)(rowbuf + G_ * 2048 + rd1);
                    if (G_ & 1) {
                        acc1 = __builtin_amdgcn_mfma_scale_f32_16x16x128_f8f6f4(p7x_a8(a0), B0, acc1, 4, 0, 0, 0x7F7F7F7F, 0, scg[G_]); acc1 = __builtin_amdgcn_mfma_scale_f32_16x16x128_f8f6f4(p7x_a8(a1), B1, acc1, 4, 0, 0, 0x7F7F7F7F, 0, scg[G_]);
                        acc1 = __builtin_amdgcn_mfma_scale_f32_16x16x128_f8f6f4(p7x_a8(a0), B2, acc1, 4, 0, 0, 0x7F7F7F7F, 0, scg[G_]); acc1 = __builtin_amdgcn_mfma_scale_f32_16x16x128_f8f6f4(p7x_a8(a1), B3, acc1, 4, 0, 0, 0x7F7F7F7F, 0, scg[G_]);
                    } else {
                        acc0 = __builtin_amdgcn_mfma_scale_f32_16x16x128_f8f6f4(p7x_a8(a0), B0, acc0, 4, 0, 0, 0x7F7F7F7F, 0, scg[G_]); acc0 = __builtin_amdgcn_mfma_scale_f32_16x16x128_f8f6f4(p7x_a8(a1), B1, acc0, 4, 0, 0, 0x7F7F7F7F, 0, scg[G_]);
                        acc0 = __builtin_amdgcn_mfma_scale_f32_16x16x128_f8f6f4(p7x_a8(a0), B2, acc0, 4, 0, 0, 0x7F7F7F7F, 0, scg[G_]); acc0 = __builtin_amdgcn_mfma_scale_f32_16x16x128_f8f6f4(p7x_a8(a1), B3, acc0, 4, 0, 0, 0x7F7F7F7F, 0, scg[G_]);
                    }
                }
                if (v + 1 < P7_TB) { P7X_BLD(); asm volatile("s_waitcnt lgkmcnt(0)" ::: "memory"); P7X_DMA(); }
                { const int vn = v + 2 < P7_TB ? v + 2 : P7_TB - 1; P7X_IDX(t0 + vn); }
                const int so_p = (int)WS_PART + ((s * M + t0 + v) * 128) * 2;
                u32x2 o_; o_.x = pk2(acc0[0] + acc1[0], acc0[1] + acc1[1]); o_.y = pk2(acc0[2] + acc1[2], acc0[3] + acc1[3]);
                __builtin_amdgcn_raw_buffer_store_b64(o_, rsrc, vo_p, so_p, 0);
            }
            asm volatile("s_waitcnt vmcnt(0)" ::: "memory");
#undef P7X_IDX
#undef P7X_HX
#undef P7X_BLD
#undef P7X_DMA
        }
    }
}
template <int NT>
__device__ __forceinline__ void p7y_tokens(const Args& A, int tb, int tstride, int lane) {
    unsigned char* ws = A.ws;
    const float* SCU = (const float*)(ws + WS_SCU);
    int jj[2];
#pragma unroll
    for (int x = 0; x < 2; ++x) { const int R_ = 2 * lane + x; jj[x] = 16 * (R_ & 7) + (R_ >> 3); }
    int iv0[NT], iv1[NT]; float gw0[NT], gw1[NT]; unsigned pw[NT][8];
#pragma unroll
    for (int n = 0; n < NT; ++n) { const int t = tb + n * tstride;
        const int* ip = (const int*)(ws + WS_IDX) + (size_t)t * 128; const float* gp = (const float*)(ws + WS_GW) + (size_t)t * 128;
        iv0[n] = ip[jj[0]]; iv1[n] = ip[jj[1]]; gw0[n] = gp[jj[0]]; gw1[n] = gp[jj[1]];
        const unsigned* pp = (const unsigned*)(ws + WS_PART) + (size_t)t * 64 + lane;
#pragma unroll
        for (int s = 0; s < 8; ++s) pw[n][s] = pp[(size_t)s * M * 64]; }
    u32x4 sa[NT], sb[NT]; float su0[NT], su1[NT];
#pragma unroll
    for (int n = 0; n < NT; ++n) { sa[n] = *(const u32x4*)(ws + WS_WDS + (size_t)iv0[n] * 16); sb[n] = *(const u32x4*)(ws + WS_WDS + (size_t)iv1[n] * 16); su0[n] = SCU[iv0[n]]; su1[n] = SCU[iv1[n]]; }
#pragma unroll
    for (int n = 0; n < NT; ++n) { const int t = tb + n * tstride;
        float dv0 = 0.f, dv1 = 0.f;
#pragma unroll
        for (int s = 0; s < 8; ++s) { const unsigned a_ = sa[n][s >> 1], b_ = sb[n][s >> 1];
            dv0 += bf_lo(pw[n][s]) * ((s & 1) ? bf_hi(a_) : bf_lo(a_)); dv1 += bf_hi(pw[n][s]) * ((s & 1) ? bf_hi(b_) : bf_lo(b_)); }
        const float c0 = gelu_tanh(dv0) * (gw0[n] * su0[n]), c1 = gelu_tanh(dv1) * (gw1[n] * su1[n]);
        const float s0_ = fminf(fmaxf(64.0f * c0, -448.0f), 448.0f), s1_ = fminf(fmaxf(64.0f * c1, -448.0f), 448.0f);
        const int hi_ = __builtin_amdgcn_cvt_pk_fp8_f32(s0_, s1_, 0, false);
        const int lo_ = __builtin_amdgcn_cvt_pk_fp8_f32(s0_ - __builtin_amdgcn_cvt_f32_fp8(hi_, 0), s1_ - __builtin_amdgcn_cvt_f32_fp8(hi_, 1), 0, false);
        unsigned char* cb = ws + WS_CB + (size_t)t * 256;
        const int rho0 = 8 * (jj[0] & 15) + (jj[0] >> 4), rho1 = 8 * (jj[1] & 15) + (jj[1] >> 4);
        cb[rho0] = (unsigned char)(hi_ & 255); cb[rho1] = (unsigned char)((hi_ >> 8) & 255); cb[128 + rho0] = (unsigned char)(lo_ & 255); cb[128 + rho1] = (unsigned char)((lo_ >> 8) & 255);
    }
}
__device__ __forceinline__ void p8x_wave(const Args& A, LAS unsigned char* lds, int wave, int lane_, int qset) {
    unsigned char* ws = A.ws;
    typedef int v2i_ __attribute__((ext_vector_type(2)));
    const __amdgpu_buffer_rsrc_t rsrc = __builtin_amdgcn_make_buffer_rsrc((void*)ws, 0, 0x7FFFFFFF, 0x00020000);
    int lane = lane_; asm volatile("" : "+v"(lane));
    LAS unsigned char* rowbuf = lds + wave * 16384;
    const int i16 = lane & 15, g = lane >> 4, l3 = lane >> 3, ih = i16 >> 1;
    const int rb = (32 * g + i16) * 128;
    const int pc0 = ((lane & 7) ^ (l3 >> 1)) << 4, pc1 = ((lane & 7) ^ (4 + (l3 >> 1))) << 4;
    const int vo_a = l3 * 64, vo_b = g * 16, vo_o = (i16 * 16 + g * 4) * 2;
    int scm[16];
#pragma unroll
    for (int m = 0; m < 16; ++m) scm[m] = (i16 == m) ? 0x79797979 : 0;
    int offp[8];
#pragma unroll
    for (int p = 0; p < 8; ++p) offp[p] = rb + ((p ^ ih) << 4);
    unsigned* Q = (unsigned*)(ws + WS_CTL + CTL_P7Q) + qset * 512;
    const int xs = (int)(xb_xcc_id() & 7u);
#pragma unroll 1
    for (int k = 0; k < 8; ++k) {
        const int s = (xs + k) & 7;
        const int so_w = (int)WS_WU4 + s * (16384 * 128);
#pragma unroll 1
        for (;;) {
            unsigned blk = 0u; if (lane == 0) blk = xb_add(Q + s * 64, 1u);
            blk = (unsigned)__builtin_amdgcn_readfirstlane((int)blk);
            if (blk >= (unsigned)(M / P7_TB)) break;
            const int t0 = (int)blk * P7_TB;
            u32x4 ea[4]; i32x8 Bh, Bl;
#define P8X_IDX(tt) do { const int so_ = (int)WS_IDX + (tt) * 512; \
            _Pragma("unroll") for (int q_ = 0; q_ < 4; ++q_) ea[q_] = __builtin_bit_cast(u32x4, __builtin_amdgcn_raw_buffer_load_b128(rsrc, vo_a + 16 * q_, so_, 0)); } while (0)
#define P8X_BLD(tt) do { const int so_ = (int)WS_CB + (tt) * 256; \
            const u32x4 b0_ = __builtin_bit_cast(u32x4, __builtin_amdgcn_raw_buffer_load_b128(rsrc, vo_b, so_, 0)), b1_ = __builtin_bit_cast(u32x4, __builtin_amdgcn_raw_buffer_load_b128(rsrc, vo_b + 64, so_, 0)); \
            const u32x4 c0_ = __builtin_bit_cast(u32x4, __builtin_amdgcn_raw_buffer_load_b128(rsrc, vo_b + 128, so_, 0)), c1_ = __builtin_bit_cast(u32x4, __builtin_amdgcn_raw_buffer_load_b128(rsrc, vo_b + 192, so_, 0)); \
            Bh = (i32x8){(int)b0_.x, (int)b0_.y, (int)b0_.z, (int)b0_.w, (int)b1_.x, (int)b1_.y, (int)b1_.z, (int)b1_.w}; \
            Bl = (i32x8){(int)c0_.x, (int)c0_.y, (int)c0_.z, (int)c0_.w, (int)c1_.x, (int)c1_.y, (int)c1_.z, (int)c1_.w}; } while (0)
#define P8X_DMA() do { _Pragma("unroll") for (int i = 0; i < 16; ++i) __builtin_amdgcn_raw_ptr_buffer_load_lds(rsrc, (LAS void*)(rowbuf + i * 1024), 16, (int)(ea[i >> 2][i & 3] * 128u) + ((i & 1) ? pc1 : pc0), so_w, 0, 0); } while (0)
            P8X_IDX(t0);
            P8X_BLD(t0);
            P8X_DMA();
            P8X_IDX(t0 + 1);
            __builtin_amdgcn_raw_buffer_store_b32(0u, rsrc, lane * 4, (int)WS_CTL + 950 * 1024, 0);
#pragma unroll 1
            for (int v = 0; v < P7_TB; ++v) {
                if (v == 0) asm volatile("s_waitcnt vmcnt(0)" ::: "memory"); else asm volatile("s_waitcnt vmcnt(1)" ::: "memory");
                f32x4 acc0 = {0.f, 0.f, 0.f, 0.f}, acc1 = {0.f, 0.f, 0.f, 0.f};
#pragma unroll
                for (int m = 0; m < 16; ++m) {
                    const v2i_ r0 = __builtin_amdgcn_ds_read_tr4_b64_v2i32((LAS v2i_*)(rowbuf + offp[m >> 1] + (m & 1) * 8)), r1 = __builtin_amdgcn_ds_read_tr4_b64_v2i32((LAS v2i_*)(rowbuf + offp[m >> 1] + 2048 + (m & 1) * 8));
                    const i32x8 a_ = (i32x8){r0.x, r0.y, r1.x, r1.y, 0, 0, 0, 0};
                    if (m & 1) { acc1 = __builtin_amdgcn_mfma_scale_f32_16x16x128_f8f6f4(a_, Bh, acc1, 4, 0, 0, 0x7F7F7F7F, 0, scm[m]); acc1 = __builtin_amdgcn_mfma_scale_f32_16x16x128_f8f6f4(a_, Bl, acc1, 4, 0, 0, 0x7F7F7F7F, 0, scm[m]); }
                    else         { acc0 = __builtin_amdgcn_mfma_scale_f32_16x16x128_f8f6f4(a_, Bh, acc0, 4, 0, 0, 0x7F7F7F7F, 0, scm[m]); acc0 = __builtin_amdgcn_mfma_scale_f32_16x16x128_f8f6f4(a_, Bl, acc0, 4, 0, 0, 0x7F7F7F7F, 0, scm[m]); }
                }
                if (v + 1 < P7_TB) { asm volatile("s_waitcnt lgkmcnt(0)" ::: "memory"); P8X_DMA(); P8X_BLD(t0 + v + 1); }
                { const int vn = v + 2 < P7_TB ? v + 2 : P7_TB - 1; P8X_IDX(t0 + vn); }
                u32x2 o_; o_.x = pk2(acc0[0] + acc1[0], acc0[1] + acc1[1]); o_.y = pk2(acc0[2] + acc1[2], acc0[3] + acc1[3]);
                __builtin_amdgcn_raw_buffer_store_b64(o_, rsrc, vo_o, (int)WS_PO + ((t0 + v) * 2048 + 256 * s) * 2, 0);
            }
            asm volatile("s_waitcnt vmcnt(0)" ::: "memory");
#undef P8X_IDX
#undef P8X_BLD
#undef P8X_DMA
        }
    }
}
__device__ __forceinline__ void p7c_token(const Args& A, int t, int lane) {
    float* orow = A.out + (size_t)t * 2048; const bf16_t* prow = (const bf16_t*)(A.ws + WS_PO) + (size_t)t * 2048; const bf16_t* xrow = (const bf16_t*)(A.ws + WS_GA) + (size_t)t * 2048; const float* g = A.in[18];
    f32x4 y[8]; float s2 = 0.f;
#pragma unroll
    for (int j = 0; j < 4; ++j) { const u32x4 p = *(const u32x4*)(prow + 512 * j + 8 * lane), x = *(const u32x4*)(xrow + 512 * j + 8 * lane);
        y[2 * j] = (f32x4){bf_lo(p.x) + bf_lo(x.x), bf_hi(p.x) + bf_hi(x.x), bf_lo(p.y) + bf_lo(x.y), bf_hi(p.y) + bf_hi(x.y)};
        y[2 * j + 1] = (f32x4){bf_lo(p.z) + bf_lo(x.z), bf_hi(p.z) + bf_hi(x.z), bf_lo(p.w) + bf_lo(x.w), bf_hi(p.w) + bf_hi(x.w)};
        s2 += (y[2 * j].x * y[2 * j].x + y[2 * j].y * y[2 * j].y) + (y[2 * j].z * y[2 * j].z + y[2 * j].w * y[2 * j].w) + (y[2 * j + 1].x * y[2 * j + 1].x + y[2 * j + 1].y * y[2 * j + 1].y) + (y[2 * j + 1].z * y[2 * j + 1].z + y[2 * j + 1].w * y[2 * j + 1].w); }
    const float rs2 = __builtin_amdgcn_rsqf(dpp_sum(s2) * (1.0f / 2048.0f) + EPS);
#pragma unroll
    for (int j = 0; j < 4; ++j) { const f32x4 g0 = *(const f32x4*)(g + 512 * j + 8 * lane), g1 = *(const f32x4*)(g + 512 * j + 8 * lane + 4);
        *(f32x4*)(orow + 512 * j + 8 * lane) = y[2 * j] * rs2 * g0; *(f32x4*)(orow + 512 * j + 8 * lane + 4) = y[2 * j + 1] * rs2 * g1; }
}

__global__ void __launch_bounds__(NWAVES * 64, 2) fwd(Args args) {
    extern __shared__ __attribute__((aligned(16))) unsigned char lds_raw[];
    LAS unsigned char* lds = (LAS unsigned char*)lds_raw;
    const int tid = threadIdx.x, lane = tid & 63, wave = __builtin_amdgcn_readfirstlane(tid >> 6);
    const int G = gridDim.x; const int bx = blockIdx.x; const int vcu = (G % 8 == 0) ? (bx % 8) * (G / 8) + bx / 8 : bx;
    unsigned char* ws = args.ws;
    unsigned* ctl = (unsigned*)(ws + WS_CTL);
    for (int u = tid; u < (LDS_BYTES - LDSCTL_OFF) / 4; u += NWAVES * 64) ((LAS unsigned*)(lds + LDSCTL_OFF))[u] = 0u;
    __syncthreads();
    const int lo = args.ph_lo, hi = args.ph_hi;
    const XcdBarrier bar = xcd_barrier_post(ctl + CW_BAR + args.li * XCD_BAR_WORDS, (volatile LAS unsigned*)(lds + LDSCTL_OFF + 64));
#define IN(k) (((PH_MASK >> (k)) & 1) && lo <= (k) && (k) < hi)
#define BOTH(k) (IN(k) && IN((k) + 1))
#define GRID_BAR() xcd_barrier(bar)

    if (IN(0)) { p0_prologue(args, lds, vcu, G, wave, lane, tid); if (BOTH(0)) GRID_BAR(); }

    if (IN(1)) {
        const bool split = G > 64;
        if (!split || bx < 32) { SchedP1 S{G, bx, (unsigned)WS_H1, (unsigned)WS_WIN, (unsigned)WS_MEMN, (unsigned)WS_WKV, 0, 32};
            EpiP1 E{(bf16_t*)(ws + WS_GA), (bf16_t*)(ws + WS_BG), (bf16_t*)(ws + WS_CH), (bf16_t*)(ws + WS_KF), (bf16_t*)(ws + WS_VF)};
            pg8::gemm_phase<EpiP1, SchedP1>(lds, ws, 2048, S, E); }
        if (!split) p0b_convert(args, lds, vcu, G, wave, lane);
        else if (bx >= 32) p0b_convert(args, lds, bx - 32, G - 32, wave, lane);
        if (BOTH(1)) GRID_BAR();
    }

    if (IN(2)) {
        {
            LAS unsigned char* sigt = lds + LDSCTL_OFF + 8192;
            for (int i = tid; i < 4096; i += NWAVES * 64) { const float v = ((float)(i - 2048) + 0.5f) * (1.0f / 128.0f); sigt[i] = (unsigned char)fminf(fmaxf(floorf(256.0f * sigmoidf_(v)), 0.0f), 255.0f); }
            LAS unsigned short* gelt = (LAS unsigned short*)(lds + LDSCTL_OFF + 12288);
            for (int i = tid; i < 8192; i += NWAVES * 64) { const float x = ((float)(i - 4096) + 0.5f) * (1.0f / 512.0f);
                const float t = x * (1.0f + 0.044715f * x * x) * (-2.302208198f); gelt[i] = __builtin_bit_cast(unsigned short, (_Float16)__builtin_amdgcn_rcpf(1.0f + __builtin_amdgcn_exp2f(t))); }
            __syncthreads();
        }
        { SchedP1F S{G, bx, (unsigned)WS_H8, (unsigned)WS_W8};
          EpiP1F E{(bf16_t*)(ws + WS_GA), (bf16_t*)(ws + WS_BG), (bf16_t*)(ws + WS_CH), (bf16_t*)(ws + WS_Q), ws + WS_SG8, (const float*)(ws + WS_HS), (const unsigned*)(ws + WS_CTL + CTL_CMX), (LAS const unsigned char*)(lds + LDSCTL_OFF + 8192), (LAS const unsigned short*)(lds + LDSCTL_OFF + 12288)};
          pg8::gemm_phase<EpiP1F, SchedP1F, 2>(lds, ws, 1024, S, E); }
        if (BOTH(2)) GRID_BAR();
    }

    if (IN(3)) {
        _Pragma("unroll 1") for (int rep = 0; rep < P2_REP_G; ++rep) { asm volatile("" ::: "memory"); for (int blk = vcu; blk < M / 128; blk += G) p2_gmlp_block(args, lds, blk, wave, lane, tid); }
        _Pragma("unroll 1") for (int rep = 0; rep < P2_REP_C; ++rep) { asm volatile("" ::: "memory"); p2_conv(args, lds, vcu, G, tid); }
        _Pragma("unroll 1") for (int rep = 0; rep < P2_REP_A; ++rep) { asm volatile("" ::: "memory"); for (int a = vcu; a < 512; a += G) { const int b = a >> 7, h = (a >> 5) & 3, qt = a & 31; p2_attn_unit(args, lds, b, h, qt * 256 + wave * 32, lane, tid); } __syncthreads(); }
        if (BOTH(3)) GRID_BAR();
    }

    if (IN(4)) {
        {
#pragma unroll 1
            for (int n = 0; n < 3; n += 2) {
                const bf16_t* src = (const bf16_t*)(ws + (n == 0 ? WS_YA : (n == 1 ? WS_BG : WS_YC))); unsigned char* dst = ws + (n == 0 ? WS_A80 : (n == 1 ? WS_A81 : WS_A82));
                for (int r = vcu * NWAVES + wave; r < M; r += 4 * G * NWAVES) rows_q8<2, 4>(src, dst, (float*)(ws + WS_RA) + n * M, r, G * NWAVES, M - 1, 1.0f, lane); }
            GRID_BAR();
        }
        SchedP3I S{G, bx};
        EpiP3I E{ws + WS_H1, ws + WS_SG8, (unsigned*)(ws + WS_CTL + CTL_RM), (unsigned*)(ws + WS_CTL + CTL_CNT3), (LAS const unsigned char*)(lds + LDSCTL_OFF + 8192)};
        pg8::gemm_phase<EpiP3I, SchedP3I, 2>(lds, ws, 512, S, E);
        if (BOTH(4)) GRID_BAR();
    }

    if (IN(5)) {
        SchedP4I S{G, bx, (unsigned)WS_H1, (unsigned)WS_WOUT};
        EpiP4I E{args.in[0], (bf16_t*)(ws + WS_GA), (float*)(ws + WS_SSP), (LAS const unsigned char*)(lds + LDSCTL_OFF + 4096)};
        pg8::gemm_phase<EpiP4I, SchedP4I, 2>(lds, ws, 1024, S, E);
        if (BOTH(5)) GRID_BAR();
    }

    if (IN(6)) {
        {
            for (int r = vcu * NWAVES + wave; r < M; r += 4 * G * NWAVES) rows_q8<4, 4>((const bf16_t*)(ws + WS_GA), ws + WS_H8, (float*)(ws + WS_HS), r, G * NWAVES, M - 1, 0.0f, lane);
            GRID_BAR();
        }
        SchedP5I S{G, bx, (unsigned)WS_H8, (unsigned)WS_WQ};
        EpiP5I E{(bf16_t*)(ws + WS_PQ), (LAS const unsigned char*)(lds + LDSCTL_OFF + 4096)};
        pg8::gemm_phase<EpiP5I, SchedP5I, 2>(lds, ws, 1024, S, E);
        if (BOTH(6)) GRID_BAR();
    }

    if (IN(7)) {
        for (int it = vcu; it < 256; it += G) {
            const int head = it & 7, chunk = it >> 3;
            __syncthreads();
            {
                const u32x4* src = (const u32x4*)(ws + WS_KEYF) + (size_t)head * 4096;
#pragma unroll
                for (int j = 0; j < 8; ++j) *(LAS u32x4*)(lds + (size_t)(j * 512 + tid) * 16) = src[j * 512 + tid];
            }
            __syncthreads();
#pragma unroll 1
            for (int q = 0; q < 4; ++q) { asm volatile("" ::: "memory"); p6_tile(args, lds, head, chunk * 1024 + (q * 8 + wave) * 32, wave, lane); }
        }
        if (BOTH(7)) GRID_BAR();
    }

    if (IN(8)) {
        _Pragma("unroll 1") for (int rep = 0; rep < P7X_REP; ++rep) { asm volatile("" ::: "memory"); p7x_wave(args, lds, wave, lane, args.li * 4 + rep); GRID_BAR(); }
        _Pragma("unroll 1") for (int rep = 0; rep < P7Y_REP; ++rep) { asm volatile("" ::: "memory");
            if (M % (G * NWAVES * 8) == 0) { _Pragma("unroll 1") for (int t = vcu * NWAVES + wave; t < M; t += G * NWAVES * 8) p7y_tokens<8>(args, t, G * NWAVES, lane); }
            else if (M % (G * NWAVES * 4) == 0) { _Pragma("unroll 1") for (int t = vcu * NWAVES + wave; t < M; t += G * NWAVES * 4) p7y_tokens<4>(args, t, G * NWAVES, lane); }
            else { _Pragma("unroll 1") for (int t = vcu * NWAVES + wave; t < M; t += G * NWAVES) p7y_tokens<1>(args, t, G * NWAVES, lane); } }
        GRID_BAR();
        _Pragma("unroll 1") for (int rep = 0; rep < P8X_REP; ++rep) { asm volatile("" ::: "memory"); p8x_wave(args, lds, wave, lane, args.li * 4 + 2 + rep); if (rep + 1 < P8X_REP) GRID_BAR(); }
        if (BOTH(8)) GRID_BAR();
    }
    if (IN(9)) {
        for (int t = vcu * NWAVES + wave; t < M; t += G * NWAVES) p7c_token(args, t, lane);
    }
#undef IN
#undef BOTH
#undef GRID_BAR
}

extern "C" void kernel_launch(void* const* d_in, const int* in_sizes, int n_in, void* d_out, int out_size, void* d_ws, size_t ws_size, hipStream_t stream) {
    static int grid = 0;
    if (grid == 0) {
        if (n_in != 19 || out_size != M * D || ws_size < WS_END) { fprintf(stderr, "kernel_launch: unexpected shapes (n_in %d out %d ws %zu)\n", n_in, out_size, ws_size); grid = -1; return; }
        int dev = 0, cus = 0, per_cu = 0;
        if (hipGetDevice(&dev) != hipSuccess || hipDeviceGetAttribute(&cus, hipDeviceAttributeMultiprocessorCount, dev) != hipSuccess) { grid = -1; return; }
        if (hipFuncSetAttribute((const void*)fwd, hipFuncAttributeMaxDynamicSharedMemorySize, LDS_BYTES) != hipSuccess) { fprintf(stderr, "kernel_launch: hipFuncSetAttribute failed\n"); grid = -1; return; }
        if (hipOccupancyMaxActiveBlocksPerMultiprocessor(&per_cu, (const void*)fwd, NWAVES * 64, LDS_BYTES) != hipSuccess || per_cu < 1) { fprintf(stderr, "kernel_launch: occupancy query says %d\n", per_cu); }
        (void)hipGetLastError();
        grid = cus;
    }
    if (grid < 0) return;
    (void)hipMemsetAsync((char*)d_ws + WS_CTL, 0, CTL_ZERO_BYTES, stream);
    Args a{};
    for (int i = 0; i < 19; ++i) a.in[i] = (const float*)d_in[i];
    a.out = (float*)d_out; a.ws = (unsigned char*)d_ws;
#if MK_SPLIT
    static const int seq[] = MK_SEQ;
    for (int i = 0; i < (int)(sizeof(seq) / sizeof(seq[0])); ++i) { a.ph_lo = seq[i]; a.ph_hi = seq[i] + 1; a.li = i; hipLaunchKernelGGL(fwd, dim3(grid), dim3(NWAVES * 64), LDS_BYTES, stream, a); }
#else
    a.ph_lo = 0; a.ph_hi = NPHASE;
    hipLaunchKernelGGL(fwd, dim3(grid), dim3(NWAVES * 64), LDS_BYTES, stream, a);
#endif
}
```
